# Optimizing an MI355X kernel written in HIP

```python
import math
import jax, jax.numpy as jnp
from jax import lax
import numpy as np

D_MODEL = 1024
BATCH = 4
SEQ = 4096
DEPTH = 1

HEAD_DIM_A = 64
N_HEADS_A = 8
WIDTH_A = N_HEADS_A * HEAD_DIM_A
DILATED_BRANCHES = ((128, 1), (512, 4), (2048, 16))

N_HEADS_B = 8
QK_NOPE_DIM = 64
QK_ROPE_DIM = 32
V_HEAD_DIM = 64
QK_HEAD_DIM_B = QK_NOPE_DIM + QK_ROPE_DIM
Q_LORA_RANK = 768
KV_LORA_RANK = 256
WIDTH_B = N_HEADS_B * V_HEAD_DIM
ROPE_THETA = 10000.0

MIX_WIDTH = WIDTH_A + WIDTH_B
D_FF = 4 * D_MODEL

REL_BUCKETS = 32
REL_MAX_DIST = 2048
Q_BLOCK = 128
EPS = 1e-6

IN_SPLITS = (WIDTH_A, WIDTH_A, WIDTH_A, Q_LORA_RANK, KV_LORA_RANK, QK_ROPE_DIM)
IN_WIDTH = sum(IN_SPLITS)

kernel_name = "hybrid_dilated_mla_sqrelu_layer"


def rms_norm(x, g):
    xf = x.astype(jnp.float32)
    y = xf * lax.rsqrt(jnp.mean(xf * xf, axis=-1, keepdims=True) + EPS)
    return (y * g.astype(jnp.float32)).astype(x.dtype)


def t5_causal_bucket(dist):
    dist = np.asarray(dist, dtype=np.int64)
    max_exact = REL_BUCKETS // 2
    safe = np.maximum(dist, 1).astype(np.float32)
    large = max_exact + (np.log(safe / max_exact) / math.log(REL_MAX_DIST / max_exact)
                         * (REL_BUCKETS - max_exact)).astype(np.int64)
    large = np.minimum(large, REL_BUCKETS - 1)
    return np.where(dist < max_exact, dist, large).astype(np.int32)


def apply_rope(x, positions):
    r = x.shape[-1]
    inv_freq = 1.0 / (ROPE_THETA ** (jnp.arange(0, r, 2, dtype=jnp.float32) / r))
    ang = positions.astype(jnp.float32)[..., None] * inv_freq
    cos = jnp.cos(ang)[:, :, None, :]
    sin = jnp.sin(ang)[:, :, None, :]
    xf = x.astype(jnp.float32)
    x1, x2 = xf[..., : r // 2], xf[..., r // 2:]
    out = jnp.concatenate([x1 * cos - x2 * sin, x2 * cos + x1 * sin], axis=-1)
    return out.astype(x.dtype)


def to_query_blocks(t):
    b, s = t.shape[:2]
    nblk = s // Q_BLOCK
    return jnp.moveaxis(t.reshape((b, nblk, Q_BLOCK) + t.shape[2:]), 1, 0)


def from_query_blocks(t):
    t = jnp.moveaxis(t, 0, 1)
    return t.reshape((t.shape[0], t.shape[1] * t.shape[2]) + t.shape[3:])


def dilated_attention(q, k, v, rel_bias):
    b, s, h, dh = q.shape
    scale = 1.0 / math.sqrt(dh)
    branches = []
    for window, dil in DILATED_BRANCHES:
        offs_np = dil * np.arange(window // dil + 1, dtype=np.int32)
        bias = rel_bias[jnp.asarray(t5_causal_bucket(offs_np))].T.astype(jnp.float32)
        branches.append((jnp.asarray(offs_np), bias))
    nblk = s // Q_BLOCK

    def block_fn(args):
        i, qi = args
        tq = i * Q_BLOCK + jnp.arange(Q_BLOCK, dtype=jnp.int32)
        ms, ss, os_ = [], [], []
        for offs, bias in branches:
            idx = tq[:, None] - offs[None, :]
            valid = idx >= 0
            idxc = jnp.maximum(idx, 0)
            kg = k[:, idxc]
            vg = v[:, idxc]
            logits = jnp.einsum('bqhd,bqkhd->bhqk', qi, kg).astype(jnp.float32) * scale
            logits = logits + bias[None, :, None, :]
            logits = jnp.where(valid[None, None], logits, -jnp.inf)
            m = jnp.max(logits, axis=-1, keepdims=True)
            p = jnp.exp(logits - m)
            den = jnp.sum(p, axis=-1, keepdims=True)
            o = jnp.einsum('bhqk,bqkhd->bhqd', p, vg.astype(jnp.float32)) / den
            ms.append(m); ss.append(den); os_.append(o)
        m_all = jnp.stack(ms)
        w = jnp.stack(ss) * jnp.exp(m_all - jnp.max(m_all, axis=0, keepdims=True))
        out = jnp.sum(w * jnp.stack(os_), axis=0) / jnp.sum(w, axis=0)
        return jnp.transpose(out, (0, 2, 1, 3)).astype(q.dtype)

    out = lax.map(block_fn, (jnp.arange(nblk, dtype=jnp.int32), to_query_blocks(q)))
    return from_query_blocks(out)


def causal_block_attention(q, k, v):
    b, s, h, dqk = q.shape
    scale = 1.0 / math.sqrt(dqk)
    kpos = jnp.arange(s, dtype=jnp.int32)
    nblk = s // Q_BLOCK

    def block_fn(args):
        i, qi = args
        tq = i * Q_BLOCK + jnp.arange(Q_BLOCK, dtype=jnp.int32)
        logits = jnp.einsum('bqhd,bkhd->bhqk', qi, k).astype(jnp.float32) * scale
        logits = jnp.where((kpos[None, :] <= tq[:, None])[None, None], logits, -jnp.inf)
        p = jax.nn.softmax(logits, axis=-1)
        out = jnp.einsum('bhqk,bkhd->bqhd', p, v.astype(jnp.float32))
        return out.astype(q.dtype)

    out = lax.map(block_fn, (jnp.arange(nblk, dtype=jnp.int32), to_query_blocks(q)))
    return from_query_blocks(out)


def setup_inputs(seed: int = 0) -> dict:
    key = jax.random.key(seed)
    ks = jax.random.split(key, 20)
    f32 = jnp.float32

    def nrm(k, shape, fan_in):
        return jax.random.normal(k, shape, f32) * (fan_in ** -0.5)

    def gain(k, n):
        return 1.0 + 0.05 * jax.random.normal(k, (n,), f32)

    x = jax.random.normal(ks[0], (BATCH, SEQ, D_MODEL), f32)
    offset = jax.random.randint(ks[1], (BATCH, 1), 0, 1024, dtype=jnp.int32)
    positions = jnp.arange(SEQ, dtype=jnp.int32)[None, :] + offset
    return {
        "x": x,
        "positions": positions,
        "norm_mix_g": gain(ks[2], D_MODEL),
        "w_in": nrm(ks[3], (D_MODEL, IN_WIDTH), D_MODEL),
        "qnorm_a_g": gain(ks[4], HEAD_DIM_A),
        "knorm_a_g": gain(ks[5], HEAD_DIM_A),
        "rel_bias": 0.5 * jax.random.normal(ks[6], (REL_BUCKETS, N_HEADS_A), f32),
        "cq_norm_g": gain(ks[7], Q_LORA_RANK),
        "ckv_norm_g": gain(ks[8], KV_LORA_RANK),
        "w_uq": nrm(ks[9], (Q_LORA_RANK, N_HEADS_B * QK_HEAD_DIM_B), Q_LORA_RANK),
        "w_ukv": nrm(ks[10], (KV_LORA_RANK, N_HEADS_B * (QK_NOPE_DIM + V_HEAD_DIM)), KV_LORA_RANK),
        "qnorm_b_g": gain(ks[11], QK_HEAD_DIM_B),
        "knorm_b_g": gain(ks[12], QK_HEAD_DIM_B),
        "w_o": nrm(ks[13], (MIX_WIDTH, D_MODEL), MIX_WIDTH),
        "norm_ffn_g": gain(ks[14], D_MODEL),
        "w_ff1": nrm(ks[15], (D_MODEL, D_FF), D_MODEL),
        "w_ff2": nrm(ks[16], (D_FF, D_MODEL), D_FF),
    }


def reference(x, positions, norm_mix_g, w_in, qnorm_a_g, knorm_a_g, rel_bias,
              cq_norm_g, ckv_norm_g, w_uq, w_ukv, qnorm_b_g, knorm_b_g, w_o,
              norm_ffn_g, w_ff1, w_ff2):
    b, s, _ = x.shape
    h = x
    for _layer in range(DEPTH):
        xn = rms_norm(h, norm_mix_g)
        proj = jnp.einsum('bsd,de->bse', xn, w_in)
        cuts = list(np.cumsum(IN_SPLITS)[:-1])
        qa, ka, va, c_q, c_kv, k_rope = jnp.split(proj, cuts, axis=-1)

        qa = rms_norm(qa.reshape(b, s, N_HEADS_A, HEAD_DIM_A), qnorm_a_g)
        ka = rms_norm(ka.reshape(b, s, N_HEADS_A, HEAD_DIM_A), knorm_a_g)
        va = va.reshape(b, s, N_HEADS_A, HEAD_DIM_A)
        out_a = dilated_attention(qa, ka, va, rel_bias).reshape(b, s, WIDTH_A)

        qb = jnp.einsum('bsr,re->bse', rms_norm(c_q, cq_norm_g), w_uq)
        qb = qb.reshape(b, s, N_HEADS_B, QK_HEAD_DIM_B)
        kv = jnp.einsum('bsr,re->bse', rms_norm(c_kv, ckv_norm_g), w_ukv)
        kv = kv.reshape(b, s, N_HEADS_B, QK_NOPE_DIM + V_HEAD_DIM)
        k_nope, vb = kv[..., :QK_NOPE_DIM], kv[..., QK_NOPE_DIM:]
        k_rope_h = jnp.broadcast_to(k_rope[:, :, None, :], (b, s, N_HEADS_B, QK_ROPE_DIM))
        kb = jnp.concatenate([k_nope, k_rope_h], axis=-1)
        qb = rms_norm(qb, qnorm_b_g)
        kb = rms_norm(kb, knorm_b_g)
        qb = jnp.concatenate([qb[..., :QK_NOPE_DIM],
                              apply_rope(qb[..., QK_NOPE_DIM:], positions)], axis=-1)
        kb = jnp.concatenate([kb[..., :QK_NOPE_DIM],
                              apply_rope(kb[..., QK_NOPE_DIM:], positions)], axis=-1)
        out_b = causal_block_attention(qb, kb, vb).reshape(b, s, WIDTH_B)

        mixed = jnp.concatenate([out_a, out_b], axis=-1)
        h = h + jnp.einsum('bse,ed->bsd', mixed, w_o)

        hn = rms_norm(h, norm_ffn_g)
        hid = jnp.square(jax.nn.relu(jnp.einsum('bsd,df->bsf', hn, w_ff1)))
        h = h + jnp.einsum('bsf,fd->bsd', hid, w_ff2)
    return h
```

```cpp
#include <hip/hip_runtime.h>
#include <cstdio>
#include <cstdint>
namespace pg8 {
#define PG8_LAS __attribute__((address_space(3)))
typedef unsigned short bf16_t;
typedef short bf16x8 __attribute__((ext_vector_type(8)));
typedef float f32x4 __attribute__((ext_vector_type(4)));
typedef unsigned u32x4 __attribute__((ext_vector_type(4)));
constexpr int BM = 256, BK = 64, HALF = 128, HTB = HALF * BK * 2  , STAGE_BYTES = 8 * HTB, NXCD = 8, WGM = 8;

__host__ __device__ __forceinline__ int lds_byte(int r, int c) { const int st = (r >> 4) * 2 + (c >> 5), rr = r & 15, cc = c & 31, ob = rr * 64 + cc * 2; return st * 1024 + (ob ^ (((ob >> 9) & 1) << 5)); }
__host__ __device__ __forceinline__ void stage_rc(int b, int& R, int& C) { const int st = b / 1024, sb = b % 1024, swz = sb ^ (((sb >> 9) & 1) << 5); R = (st >> 1) * 16 + swz / 64; C = (st & 1) * 32 + (swz % 64) / 2; }
__host__ __device__ __forceinline__ int perm32(int rho) { const int n = rho >> 4, i = rho & 15; return 8 * (i >> 2) + 4 * n + (i & 3); }

struct Unit { int pm, pn; };
struct Gemm { const bf16_t* A; const bf16_t* Bt; int M, N, K; };

struct StaticOrder {
    int nM, nN, nwg, G, c;
    __host__ __device__ void init(int M, int N, int G_, int c_) { nM = M / BM; nN = N / BM; nwg = nM * nN; G = G_; c = c_; }
    __host__ __device__ bool next(int i, Unit& u) const {
        const long L = (long)i * G + c; if (L >= nwg) return false;
        int wgid = (int)L; { const int q = nwg / NXCD, r = nwg % NXCD, xcd = wgid % NXCD, off = wgid / NXCD; wgid = (xcd < r ? xcd * (q + 1) : r * (q + 1) + (xcd - r) * q) + off; }
        const int nig = WGM * nN, gid = wgid / nig, fm = gid * WGM, gsz = (nM - fm) < WGM ? (nM - fm) : WGM;
        u.pm = fm + ((wgid % nig) % gsz); u.pn = (wgid % nig) / gsz; return true;
    }
    __device__ __forceinline__ void a_ready(const Unit&) const {}
    __device__ __forceinline__ void done(const Unit&) const {}
};

__device__ __forceinline__ unsigned cvt_pk_bf16(float lo, float hi) { unsigned r; asm volatile("v_cvt_pk_bf16_f32 %0, %1, %2" : "=v"(r) : "v"(lo), "v"(hi)); return r; }
__device__ __forceinline__ u32x4 pack8(const f32x4 v0, const f32x4 v1) { u32x4 w; w.x = cvt_pk_bf16(v0[0], v0[1]); w.y = cvt_pk_bf16(v0[2], v0[3]); w.z = cvt_pk_bf16(v1[0], v1[1]); w.w = cvt_pk_bf16(v1[2], v1[3]); return w; }

struct EpiBf16P {
    static constexpr bool PERM = true, AFTER_DRAIN = false;
    bf16_t* O; int ldc;
    __device__ __forceinline__ void operator()(const f32x4 (&acc)[2][2][4][2], const Unit& u, int wr, int wc, int fr, int fq) const {
        const int row0 = u.pm * BM + wr * 64 + fr, col0 = u.pn * BM + wc * 32 + 8 * fq;
#pragma unroll
        for (int ai = 0; ai < 2; ++ai)
#pragma unroll
            for (int m = 0; m < 4; ++m) { bf16_t* rowp = O + (size_t)(row0 + ai * HALF + m * 16) * ldc + col0;
#pragma unroll
                for (int bj = 0; bj < 2; ++bj) *(u32x4*)(rowp + bj * HALF) = pack8(acc[ai][bj][m][0], acc[ai][bj][m][1]); }
    }
};
struct EpiSplit {
    static constexpr bool PERM = true, AFTER_DRAIN = false;
    bf16_t *QA, *KA, *VA, *CQ, *CKV, *KRR;
    __device__ __forceinline__ void operator()(const f32x4 (&acc)[2][2][4][2], const Unit& u, int wr, int wc, int fr, int fq) const {
        const int pn = u.pn; bf16_t* base; int ldc, c0, lim = 256;
        if (pn < 2) { base = QA; ldc = 512; c0 = 256 * pn; } else if (pn < 4) { base = KA; ldc = 512; c0 = 256 * (pn - 2); } else if (pn < 6) { base = VA; ldc = 512; c0 = 256 * (pn - 4); }
        else if (pn < 9) { base = CQ; ldc = 768; c0 = 256 * (pn - 6); } else if (pn == 9) { base = CKV; ldc = 256; c0 = 0; } else { base = KRR; ldc = 32; c0 = 0; lim = 32; }
        const int row0 = u.pm * BM + wr * 64 + fr, col0 = wc * 32 + 8 * fq;
#pragma unroll
        for (int ai = 0; ai < 2; ++ai)
#pragma unroll
            for (int m = 0; m < 4; ++m) { bf16_t* rowp = base + (size_t)(row0 + ai * HALF + m * 16) * ldc + c0 + col0;
#pragma unroll
                for (int bj = 0; bj < 2; ++bj) if (col0 + bj * HALF < lim) *(u32x4*)(rowp + bj * HALF) = pack8(acc[ai][bj][m][0], acc[ai][bj][m][1]); }
    }
};
struct EpiF32Res {
    static constexpr bool PERM = true, AFTER_DRAIN = false;
    const float* base; float* out; int ldc;
    __device__ __forceinline__ void operator()(const f32x4 (&acc)[2][2][4][2], const Unit& u, int wr, int wc, int fr, int fq) const {
        const int row0 = u.pm * BM + wr * 64 + fr, col0 = u.pn * BM + wc * 32 + 8 * fq;
#pragma unroll
        for (int ai = 0; ai < 2; ++ai)
#pragma unroll
            for (int m = 0; m < 4; ++m) { const size_t off = (size_t)(row0 + ai * HALF + m * 16) * ldc + col0;
#pragma unroll
                for (int bj = 0; bj < 2; ++bj) { const f32x4 b0 = *(const f32x4*)(base + off + bj * HALF), b1 = *(const f32x4*)(base + off + bj * HALF + 4);
                    *(f32x4*)(out + off + bj * HALF) = b0 + acc[ai][bj][m][0]; *(f32x4*)(out + off + bj * HALF + 4) = b1 + acc[ai][bj][m][1]; } }
    }
};
struct EpiRelu2 {
    static constexpr bool PERM = true, AFTER_DRAIN = false;
    const float* rs; bf16_t* O; int ldc;
    __device__ __forceinline__ void operator()(const f32x4 (&acc)[2][2][4][2], const Unit& u, int wr, int wc, int fr, int fq) const {
        const int row0 = u.pm * BM + wr * 64 + fr, col0 = u.pn * BM + wc * 32 + 8 * fq;
#pragma unroll
        for (int ai = 0; ai < 2; ++ai)
#pragma unroll
            for (int m = 0; m < 4; ++m) { const int row = row0 + ai * HALF + m * 16; const float s = rs[row]; bf16_t* rowp = O + (size_t)row * ldc + col0;
#pragma unroll
                for (int bj = 0; bj < 2; ++bj) { f32x4 v0 = acc[ai][bj][m][0] * s, v1 = acc[ai][bj][m][1] * s;
#pragma unroll
                    for (int i = 0; i < 4; ++i) { const float a = fmaxf(v0[i], 0.f), b = fmaxf(v1[i], 0.f); v0[i] = a * a; v1[i] = b * b; }
                    *(u32x4*)(rowp + bj * HALF) = pack8(v0, v1); } }
    }
};
template <class Epi, class Sched, bool ALIGN_EPI = false, bool SP2 = false>
__device__ __forceinline__ void gemm_phase(PG8_LAS unsigned char* lds, const Gemm g, const Sched& S, const Epi& E) {
    const int tid = threadIdx.x, wid = __builtin_amdgcn_readfirstlane(tid >> 6), lane = tid & 63, wr = wid >> 2, wc = wid & 3, fr = lane & 15, fq = lane >> 4;
    const int K = g.K, nt = K / BK;
    unsigned voffA[2], voffB[2];
#pragma unroll
    for (int i = 0; i < 2; ++i) { int R, C; stage_rc(tid * 16 + i * 8192, R, C); const int Rb = Epi::PERM ? ((R & ~31) + perm32(R & 31)) : R;
        voffA[i] = (unsigned)(R * K + C) * 2u; voffB[i] = (unsigned)(Rb * K + C) * 2u; }
    const size_t kstep = (size_t)(BK * 2);
    const size_t hstep = (size_t)HALF * K * 2;
    const size_t tstep = 2 * hstep;
    const unsigned ldsw = (unsigned)wid * 1024u;
    const int aoff = lds_byte(wr * 64 + fr, fq * 8), boff = lds_byte(wc * 32 + fr, fq * 8);
#define PG8_SA(b, h) (((b) * 2 + (h)) * HTB)
#define PG8_SB(b, h) ((4 + (b) * 2 + (h)) * HTB)
#define PG8_STAGE(bufoff, gbase, voff) do { _Pragma("unroll") for (int _i = 0; _i < 2; ++_i) \
        __builtin_amdgcn_global_load_lds((const unsigned*)((const char*)(gbase) + (voff)[_i]), (PG8_LAS unsigned*)(lds + (bufoff) + ldsw + _i * 8192), 16, 0, 0); } while (0)
#define PG8_LDA(dst, b, h) do { _Pragma("unroll") for (int m = 0; m < 4; ++m) _Pragma("unroll") for (int k = 0; k < 2; ++k) dst[m][k] = *(const PG8_LAS bf16x8*)(lds + PG8_SA(b, h) + aoff + m * 2048 + k * 1024); } while (0)
#define PG8_LDB(dst, b, h) do { _Pragma("unroll") for (int n = 0; n < 2; ++n) _Pragma("unroll") for (int k = 0; k < 2; ++k) dst[n][k] = *(const PG8_LAS bf16x8*)(lds + PG8_SB(b, h) + boff + n * 2048 + k * 1024); } while (0)
#define PG8_MMA(ai, bj, At, Bt) do { __builtin_amdgcn_s_setprio(1); _Pragma("unroll") for (int m = 0; m < 4; ++m) _Pragma("unroll") for (int n = 0; n < 2; ++n) _Pragma("unroll") for (int k = 0; k < 2; ++k) \
        acc[ai][bj][m][n] = __builtin_amdgcn_mfma_f32_16x16x32_bf16(Bt[n][k], At[m][k], acc[ai][bj][m][n], 0, 0, 0); __builtin_amdgcn_s_setprio(0); } while (0)
#define PG8_WAIT_V(n) asm volatile("s_waitcnt vmcnt(" #n ")" ::: "memory")
#define PG8_WAIT_L(n) asm volatile("s_waitcnt lgkmcnt(" #n ")" ::: "memory")
#define PG8_BAR __builtin_amdgcn_s_barrier()
#define PG8_SCHED __builtin_amdgcn_sched_barrier(0)
    Unit cur, nxt; int ui = 0;
    if (!S.next(0, cur)) return;
    f32x4 acc[2][2][4][2];
#pragma unroll
    for (int a = 0; a < 2; ++a)
#pragma unroll
        for (int b = 0; b < 2; ++b)
#pragma unroll
            for (int m = 0; m < 4; ++m)
#pragma unroll
                for (int n = 0; n < 2; ++n) acc[a][b][m][n] = (f32x4){0.f, 0.f, 0.f, 0.f};
    bf16x8 At[4][2], B0[2][2], B1[2][2];
    const char* cA = (const char*)g.A + (size_t)cur.pm * tstep; const char* cB = (const char*)g.Bt + (size_t)cur.pn * tstep;
    S.a_ready(cur);
    if constexpr (SP2) {
        PG8_STAGE(PG8_SB(0, 0), cB, voffB); PG8_STAGE(PG8_SB(0, 1), cB + hstep, voffB); PG8_STAGE(PG8_SA(0, 0), cA, voffA); PG8_STAGE(PG8_SA(0, 1), cA + hstep, voffA);
        if (wr == 1) PG8_BAR;
        PG8_WAIT_V(2); PG8_BAR;
        PG8_STAGE(PG8_SB(1, 0), cB + kstep, voffB); PG8_STAGE(PG8_SA(1, 0), cA + kstep, voffA); PG8_STAGE(PG8_SB(1, 1), cB + hstep + kstep, voffB);
        PG8_WAIT_V(6); PG8_BAR;
    } else {
        PG8_STAGE(PG8_SB(0, 0), cB, voffB); PG8_STAGE(PG8_SA(0, 0), cA, voffA); PG8_STAGE(PG8_SB(0, 1), cB + hstep, voffB); PG8_STAGE(PG8_SA(0, 1), cA + hstep, voffA);
        if (wr == 1) PG8_BAR;
        PG8_WAIT_V(4); PG8_BAR;
        PG8_STAGE(PG8_SB(1, 0), cB + kstep, voffB); PG8_STAGE(PG8_SA(1, 0), cA + kstep, voffA); PG8_STAGE(PG8_SB(1, 1), cB + hstep + kstep, voffB);
        PG8_WAIT_V(6); PG8_BAR;
    }
    for (;;) {
        const bool has_next = S.next(ui + 1, nxt);
        const char* nA = has_next ? (const char*)g.A + (size_t)nxt.pm * tstep : cA; const char* nB = has_next ? (const char*)g.Bt + (size_t)nxt.pn * tstep : cB;
        for (int t = 0; t < nt; t += 2) {
            const bool last = (t == nt - 2);
            const char* a1 = cA + (size_t)(t + 1) * kstep;
            const char* a2 = last ? nA : cA + (size_t)(t + 2) * kstep; const char* b2 = last ? nB : cB + (size_t)(t + 2) * kstep;
            const char* a3 = a2 + kstep; const char* b3 = b2 + kstep;
            if (last && has_next) S.a_ready(nxt);
            if constexpr (SP2) {
            PG8_LDB(B0, 0, 0); PG8_LDB(B1, 0, 1); PG8_SCHED; PG8_LDA(At, 0, 0); PG8_STAGE(PG8_SA(1, 1), a1 + hstep, voffA);
            PG8_WAIT_V(8); PG8_WAIT_L(0); PG8_BAR; PG8_MMA(0, 0, At, B0); PG8_MMA(0, 1, At, B1); PG8_BAR; PG8_SCHED;
            PG8_LDA(At, 0, 1); PG8_STAGE(PG8_SB(0, 0), b2, voffB); PG8_STAGE(PG8_SB(0, 1), b2 + hstep, voffB); PG8_STAGE(PG8_SA(0, 0), a2, voffA);
            PG8_WAIT_V(8); PG8_WAIT_L(0); PG8_BAR; PG8_MMA(1, 0, At, B0); PG8_MMA(1, 1, At, B1); PG8_BAR; PG8_SCHED;
            PG8_LDB(B0, 1, 0); PG8_LDB(B1, 1, 1); PG8_SCHED; PG8_LDA(At, 1, 0); PG8_STAGE(PG8_SA(0, 1), a2 + hstep, voffA);
            PG8_WAIT_V(8); PG8_WAIT_L(0); PG8_BAR; PG8_MMA(0, 0, At, B0); PG8_MMA(0, 1, At, B1); PG8_BAR; PG8_SCHED;
            PG8_LDA(At, 1, 1); PG8_STAGE(PG8_SB(1, 0), b3, voffB); PG8_STAGE(PG8_SB(1, 1), b3 + hstep, voffB); PG8_STAGE(PG8_SA(1, 0), a3, voffA);
            PG8_WAIT_V(8); PG8_WAIT_L(0); PG8_BAR; PG8_MMA(1, 0, At, B0); PG8_MMA(1, 1, At, B1); PG8_BAR; PG8_SCHED;
            } else {
            PG8_LDB(B0, 0, 0); PG8_SCHED; PG8_LDA(At, 0, 0); PG8_STAGE(PG8_SA(1, 1), a1 + hstep, voffA);
            PG8_WAIT_L(8); PG8_BAR; PG8_WAIT_L(0); PG8_MMA(0, 0, At, B0); PG8_BAR; PG8_SCHED;
            PG8_LDB(B1, 0, 1); PG8_STAGE(PG8_SB(0, 0), b2, voffB);
            PG8_BAR; PG8_WAIT_L(0); PG8_MMA(0, 1, At, B1); PG8_BAR;
            PG8_LDA(At, 0, 1); PG8_STAGE(PG8_SA(0, 0), a2, voffA);
            PG8_BAR; PG8_WAIT_L(0); PG8_MMA(1, 0, At, B0); PG8_BAR; PG8_SCHED;
            PG8_STAGE(PG8_SB(0, 1), b2 + hstep, voffB);
            PG8_WAIT_V(6); PG8_BAR; PG8_MMA(1, 1, At, B1); PG8_BAR;
            PG8_LDB(B0, 1, 0); PG8_SCHED; PG8_LDA(At, 1, 0); PG8_STAGE(PG8_SA(0, 1), a2 + hstep, voffA);
            PG8_WAIT_L(8); PG8_BAR; PG8_WAIT_L(0); PG8_MMA(0, 0, At, B0); PG8_BAR; PG8_SCHED;
            PG8_LDB(B1, 1, 1); PG8_STAGE(PG8_SB(1, 0), b3, voffB);
            PG8_BAR; PG8_WAIT_L(0); PG8_MMA(0, 1, At, B1); PG8_BAR;
            PG8_LDA(At, 1, 1); PG8_STAGE(PG8_SA(1, 0), a3, voffA);
            PG8_BAR; PG8_WAIT_L(0); PG8_MMA(1, 0, At, B0); PG8_BAR; PG8_SCHED;
            PG8_STAGE(PG8_SB(1, 1), b3 + hstep, voffB);
            PG8_WAIT_V(6); PG8_BAR; PG8_MMA(1, 1, At, B1); PG8_BAR;
            }
        }
        if constexpr (ALIGN_EPI) { if (wr == 0) PG8_BAR; }
        if constexpr (!Epi::AFTER_DRAIN) { E(acc, cur, wr, wc, fr, fq); S.done(cur); }
        if (!has_next) break;
#pragma unroll
        for (int a = 0; a < 2; ++a)
#pragma unroll
            for (int b = 0; b < 2; ++b)
#pragma unroll
                for (int m = 0; m < 4; ++m)
#pragma unroll
                    for (int n = 0; n < 2; ++n) acc[a][b][m][n] = (f32x4){0.f, 0.f, 0.f, 0.f};
        cur = nxt; cA = nA; cB = nB; ++ui;
        if constexpr (ALIGN_EPI) { if (wr == 1) PG8_BAR; }
    }
    PG8_WAIT_V(0);
    if constexpr (!ALIGN_EPI) { if (wr == 0) PG8_BAR; }
    PG8_BAR;
    if constexpr (Epi::AFTER_DRAIN) { E.fused(acc, cur, wr, wc, fr, fq, lds, wid, lane); S.done(cur); }
#undef PG8_SA
#undef PG8_SB
#undef PG8_STAGE
#undef PG8_LDA
#undef PG8_LDB
#undef PG8_MMA
#undef PG8_WAIT_V
#undef PG8_WAIT_L
#undef PG8_BAR
#undef PG8_SCHED
}
}
#ifndef PG8_SP2
#define PG8_SP2 true
#endif
#ifndef PG8_ALIGN
#define PG8_ALIGN true
#endif
constexpr int NWAVES = 8;
#ifndef MK_N_LAUNCHES
#define MK_N_LAUNCHES 10
#endif
constexpr int BATCH = 4, SEQ = 4096, D = 1024, M = BATCH * SEQ, FF = 4096;
constexpr int HA = 8, DA = 64, WA = 512;
constexpr int HB = 8, DN = 64, DR = 32, DQK = 96, DV = 64;
constexpr int QLR = 768, KVLR = 256;
constexpr int NIN = 2592, NIN_PAD = 2816;
constexpr float EPS = 1e-6f;
constexpr float LOG2E = 1.4426950408889634f;
constexpr float QSCALE_A = 0.125f * LOG2E;
constexpr float QSCALE_B = 0.10206207261596575f * LOG2E;

constexpr size_t MiB = 1u << 20;
constexpr size_t WS_CTL = 0, CTL_ZERO_BYTES = 1 * MiB;
constexpr size_t WS_WIN = 1 * MiB;
constexpr size_t WS_WUQ = 7 * MiB;
constexpr size_t WS_WUKV = 8 * MiB + 512 * 1024;
constexpr size_t WS_WO = 9 * MiB;
constexpr size_t WS_W1 = 11 * MiB;
constexpr size_t WS_W2 = 19 * MiB;
constexpr size_t WS_CS = 27 * MiB;
constexpr size_t WS_KR = 29 * MiB;
constexpr size_t WS_RCQ = 31 * MiB;
constexpr size_t WS_RCKV = 31 * MiB + 64 * 1024;
constexpr size_t WS_SKR = 31 * MiB + 128 * 1024;
constexpr size_t WS_RH = 31 * MiB + 192 * 1024;
constexpr size_t WS_BIAS = 31 * MiB + 256 * 1024;
constexpr size_t WS_KRR = 32 * MiB;
constexpr size_t WS_XN = 36 * MiB;
constexpr size_t WS_H1B = 36 * MiB;
constexpr size_t WS_QA = 68 * MiB, WS_KA = 84 * MiB, WS_VA = 100 * MiB;
constexpr size_t WS_CQ = 116 * MiB;
constexpr size_t WS_CKV = 140 * MiB;
constexpr size_t WS_MIX = 116 * MiB;
constexpr size_t WS_QB = 148 * MiB;
constexpr size_t WS_KBN = 172 * MiB;
constexpr size_t WS_KBR = 188 * MiB;
constexpr size_t WS_VB = 196 * MiB;
constexpr size_t WS_KVR = 212 * MiB;
constexpr size_t WS_HID = 128 * MiB;
constexpr size_t WS_END = 256 * MiB;

constexpr int CW_TMO = 0, CW_CODE = 1;
constexpr int CW_BAR = 4096;
constexpr int RING_OFF = 0, RING_BYTES = 131072;
constexpr int LDSCTL_OFF = RING_BYTES, MISC_OFF = LDSCTL_OFF + 320;
constexpr int LDS_BYTES = 147456;
#define GAS __attribute__((address_space(1)))
#define LAS __attribute__((address_space(3)))
typedef unsigned short bf16;
typedef unsigned v4u __attribute__((ext_vector_type(4)));
typedef float f32x4 __attribute__((ext_vector_type(4)));
typedef short bf16x8 __attribute__((ext_vector_type(8)));
typedef GAS unsigned gu32;
typedef GAS unsigned long long gu64;
#define RLX_AGENT __ATOMIC_RELAXED, __HIP_MEMORY_SCOPE_AGENT
#define LDS_WAIT() asm volatile("s_waitcnt lgkmcnt(0)" ::: "memory")
#define VM_WAIT() asm volatile("s_waitcnt vmcnt(0)" ::: "memory")
__device__ __forceinline__ unsigned long long rt() { return __builtin_amdgcn_s_memrealtime(); }
__device__ __forceinline__ unsigned f2bf(float f) { unsigned u = __builtin_bit_cast(unsigned, f); return (u + 0x7fffu + ((u >> 16) & 1u)) >> 16; }
__device__ __forceinline__ unsigned pk2(float lo, float hi) { return f2bf(lo) | (f2bf(hi) << 16); }

#define XB_TMO      128
#define XB_XCNT(j)  (256  + 64 * (j))
#define XB_XSUB(j)  (1280 + 64 * (j))
#define XB_XGEN(j)  (2304 + 64 * (j))
#define XB_TOP      3328
#define XB_TOPGEN   3392
#define XCD_BAR_WORDS 3456
#define XB_SPIN_CAP (1u << 18)

__device__ __forceinline__ unsigned xb_ld(unsigned* p)              { return __hip_atomic_load(p, __ATOMIC_RELAXED, __HIP_MEMORY_SCOPE_AGENT); }
__device__ __forceinline__ unsigned xb_add(unsigned* p, unsigned v) { return __hip_atomic_fetch_add(p, v, __ATOMIC_RELAXED, __HIP_MEMORY_SCOPE_AGENT); }
__device__ __forceinline__ unsigned xb_xcc_id() { return (unsigned)__builtin_amdgcn_s_getreg((3 << 11) | 20) & 0xFu; }
#define XB_SPIN(cond, bar) do { unsigned _sp = 0; while (cond) { __builtin_amdgcn_s_sleep(1); \
    if ((++_sp & 255u) == 0u) { if (xb_ld(&(bar)[XB_TMO])) break; if (_sp > XB_SPIN_CAP) { atomicAdd(&(bar)[XB_TMO], 1u); break; } } } } while (0)

struct XcdBarrier {
    unsigned* bar; unsigned x;
    volatile LAS unsigned* st;
};

__device__ __forceinline__ XcdBarrier xcd_barrier_post(unsigned* bar, volatile LAS unsigned* st) {
    XcdBarrier b; b.bar = bar; b.x = xb_xcc_id(); b.st = st;
    if (threadIdx.x == 0) (void)xb_add(&bar[XB_XCNT(b.x)], 1u);
    return b;
}
__device__ __forceinline__ void xcd_barrier_complete(unsigned* bar, unsigned x, unsigned& nloc, unsigned& nx) {
    const unsigned G = gridDim.x * gridDim.y * gridDim.z;
    unsigned sum, cnt, mine, sp = 0u;
    for (;;) {
        sum = 0u; cnt = 0u; mine = 0u;
#pragma unroll
        for (unsigned j = 0; j < 16; ++j) { const unsigned c = xb_ld(&bar[XB_XCNT(j)]); sum += c; cnt += (c > 0u) ? 1u : 0u; mine = (j == x) ? c : mine; }
        if (sum == G) break;
        __builtin_amdgcn_s_sleep(1);
        if ((++sp & 255u) == 0u) { if (xb_ld(&bar[XB_TMO])) break; if (sp > XB_SPIN_CAP) { atomicAdd(&bar[XB_TMO], 1u); break; } }
    }
    nloc = mine > 0u ? mine : 1u; nx = cnt > 0u ? cnt : 1u;
}

__device__ __forceinline__ void xcd_barrier(const XcdBarrier& b) {
    asm volatile("s_waitcnt vmcnt(0)" ::: "memory");
    __syncthreads();
    if (threadIdx.x == 0) {
        unsigned* bar = b.bar;
        __builtin_amdgcn_s_waitcnt(0);
        unsigned nloc = b.st[0], nx = b.st[1];
        if (nloc == 0u) { xcd_barrier_complete(bar, b.x, nloc, nx); b.st[0] = nloc; b.st[1] = nx; }
        const unsigned old = xb_add(&bar[XB_XSUB(b.x)], 1u);
        const unsigned gen = old / nloc;
        if (old + 1u == (gen + 1u) * nloc) {
            __builtin_amdgcn_fence(__ATOMIC_RELEASE, "agent");
            asm volatile("s_waitcnt vmcnt(0)" ::: "memory");
            const unsigned og = xb_add(&bar[XB_TOP], 1u);
            const unsigned tg = og / nx;
            if (og + 1u == (tg + 1u) * nx) xb_add(&bar[XB_TOPGEN], 1u);
            else XB_SPIN(xb_ld(&bar[XB_TOPGEN]) == tg, bar);
            __builtin_amdgcn_fence(__ATOMIC_ACQUIRE, "agent");
            xb_add(&bar[XB_XGEN(b.x)], 1u);
            asm volatile("s_waitcnt vmcnt(0)" ::: "memory");
        } else {
            XB_SPIN(xb_ld(&bar[XB_XGEN(b.x)]) == gen, bar);
            __builtin_amdgcn_fence(__ATOMIC_ACQUIRE, "agent");
            asm volatile("s_waitcnt vmcnt(0)" ::: "memory");
        }
    }
    __syncthreads();
}
struct Frame {
    LAS unsigned char* lds;
    volatile LAS unsigned* MISC;
    gu32* ctl;
    int tid, lane, wave;
    int vcu, G;
};
__device__ __forceinline__ float wave_sum(float v) {
#pragma unroll
    for (int o = 1; o < 64; o <<= 1) v += __shfl_xor(v, o);
    return v;
}
__device__ __forceinline__ float bf2f(unsigned short u) { return __uint_as_float((unsigned)u << 16); }
__device__ __forceinline__ float bflo(unsigned w) { return __uint_as_float(w << 16); }
__device__ __forceinline__ float bfhi(unsigned w) { return __uint_as_float(w & 0xffff0000u); }

__device__ __forceinline__ void p0_transpose_item(const float* W, int K, int N, bf16* WT, const float* kscale, LAS float* scr, int item, int lane) {
    const int nblk = N / 32, kb = item / nblk, nb = item % nblk, k0 = 64 * kb, n0 = 32 * nb;
#pragma unroll 8
    for (int i = 0; i < 32; ++i) { const int kk = 2 * i + (lane >> 5); float w = W[(size_t)(k0 + kk) * N + n0 + (lane & 31)]; if (kscale) w *= kscale[k0 + kk]; scr[kk * 33 + (lane & 31)] = w; }
    LDS_WAIT(); asm volatile("" ::: "memory");
    const int c = lane & 7;
#pragma unroll
    for (int j = 0; j < 4; ++j) { const int n = (lane >> 3) + 8 * j; const LAS float* s = scr + (8 * c) * 33 + n;
        v4u o; o.x = pk2(s[0 * 33], s[1 * 33]); o.y = pk2(s[2 * 33], s[3 * 33]); o.z = pk2(s[4 * 33], s[5 * 33]); o.w = pk2(s[6 * 33], s[7 * 33]);
        *(GAS v4u*)(WT + (size_t)(n0 + n) * K + k0 + 8 * c) = o; }
    LDS_WAIT(); asm volatile("" ::: "memory");
}
struct In { const float* x; const int* pos; const float *g_mix, *w_in, *g_qa, *g_ka, *rel_bias, *g_cq, *g_ckv, *w_uq, *w_ukv, *g_qb, *g_kb, *w_o, *g_ffn, *w1, *w2; };

__device__ __forceinline__ float inv_freq(int k) {
    const float t[16] = {1.000000000e+00f, 5.623413324e-01f, 3.162277639e-01f, 1.778279394e-01f, 1.000000015e-01f, 5.623413250e-02f, 3.162277490e-02f, 1.778279431e-02f,
                         9.999999776e-03f, 5.623413250e-03f, 3.162277630e-03f, 1.778279431e-03f, 1.000000047e-03f, 5.623413017e-04f, 3.162277571e-04f, 1.778279402e-04f};
    float r = t[0];
#pragma unroll
    for (int i = 1; i < 16; ++i) r = (k == i) ? t[i] : r;
    return r;
}
__device__ __forceinline__ int t5_bucket(int dist) {
    if (dist < 16) return dist;
    int l = 16 + (int)(logf((float)dist * (1.0f / 16.0f)) / 4.852030263919617f * 16.0f);
    return l < 31 ? l : 31;
}
__device__ __forceinline__ void p0_prologue(Frame& F, const In& I, unsigned char* ws) {
    LAS float* scr = (LAS float*)(F.lds + RING_OFF + F.wave * 16384);
    const int gw = F.vcu * NWAVES + F.wave, NGW = F.G * NWAVES;
    const int gt = gw * 64 + F.lane, NGT = NGW * 64;
    bf16* Win = (bf16*)(ws + WS_WIN); bf16* Wuq = (bf16*)(ws + WS_WUQ); bf16* Wukv = (bf16*)(ws + WS_WUKV); bf16* Wo = (bf16*)(ws + WS_WO); bf16* W1 = (bf16*)(ws + WS_W1); bf16* W2 = (bf16*)(ws + WS_W2);
    constexpr int I_IN = (D / 64) * (NIN / 32), I_UQ = (QLR / 64) * (768 / 32), I_UKV = (KVLR / 64) * (1024 / 32), I_O = (D / 64) * (D / 32), I_1 = (D / 64) * (FF / 32), I_2 = (FF / 64) * (D / 32);
    constexpr int NITEMS = I_IN + I_UQ + I_UKV + I_O + I_1 + I_2;
    for (int it = gw; it < NITEMS; it += NGW) {
        int r = it;
        if (r < I_IN) { p0_transpose_item(I.w_in, D, NIN, Win, nullptr, scr, r, F.lane); continue; } r -= I_IN;
        if (r < I_UQ) { p0_transpose_item(I.w_uq, QLR, 768, Wuq, I.g_cq, scr, r, F.lane); continue; } r -= I_UQ;
        if (r < I_UKV) { p0_transpose_item(I.w_ukv, KVLR, 1024, Wukv, I.g_ckv, scr, r, F.lane); continue; } r -= I_UKV;
        if (r < I_O) { p0_transpose_item(I.w_o, D, D, Wo, nullptr, scr, r, F.lane); continue; } r -= I_O;
        if (r < I_1) { p0_transpose_item(I.w1, D, FF, W1, I.g_ffn, scr, r, F.lane); continue; } r -= I_1;
        p0_transpose_item(I.w2, FF, D, W2, nullptr, scr, r, F.lane);
    }
    { GAS v4u* z = (GAS v4u*)(Win + (size_t)NIN * D); const int n16 = (NIN_PAD - NIN) * D * 2 / 16; for (int i = gt; i < n16; i += NGT) z[i] = (v4u){0u, 0u, 0u, 0u}; }
    bf16* XN = (bf16*)(ws + WS_XN);
    for (int m = gw; m < M; m += NGW) {
        const GAS f32x4* xr = (const GAS f32x4*)(I.x + (size_t)m * D) + F.lane;
        f32x4 v[4]; float s2 = 0.f;
#pragma unroll
        for (int j = 0; j < 4; ++j) { v[j] = xr[64 * j]; s2 += (v[j].x * v[j].x + v[j].y * v[j].y) + (v[j].z * v[j].z + v[j].w * v[j].w); }
        const float rstd = 1.f / sqrtf(wave_sum(s2) * (1.f / D) + EPS);
        GAS unsigned long long* o8 = (GAS unsigned long long*)(XN + (size_t)m * D) + F.lane;
#pragma unroll
        for (int j = 0; j < 4; ++j) { const f32x4 g = *((const GAS f32x4*)I.g_mix + F.lane + 64 * j);
            o8[64 * j] = (unsigned long long)pk2(v[j].x * rstd * g.x, v[j].y * rstd * g.y) | ((unsigned long long)pk2(v[j].z * rstd * g.z, v[j].w * rstd * g.w) << 32); }
    }
    { float2* CS = (float2*)(ws + WS_CS);
      for (int i = gt; i < M * 16; i += NGT) { const int m = i >> 4, k = i & 15; const float ang = (float)I.pos[m] * inv_freq(k);
          const double a = (double)ang; const double n = __builtin_rint(a * 0.15915494309189535); const float r = (float)(a - n * 6.283185307179586);
          CS[i] = make_float2(__cosf(r), __sinf(r)); } }
    { float* BT = (float*)(ws + WS_BIAS);
      for (int i = gt; i < 3 * 8 * 132; i += NGT) { const int br = i / (8 * 132), h = (i / 132) % 8, j = i % 132; const int dil = br == 0 ? 1 : (br == 1 ? 4 : 16);
          BT[i] = j <= 128 ? I.rel_bias[t5_bucket(dil * j) * 8 + h] * LOG2E : 0.f; } }
}
__device__ __forceinline__ void e1_phase(Frame& F, const In& I, unsigned char* ws) {
    const int gw = F.vcu * NWAVES + F.wave, NGW = F.G * NWAVES, lane = F.lane;
    bf16* QA = (bf16*)(ws + WS_QA); bf16* KA = (bf16*)(ws + WS_KA); const bf16* CQ = (const bf16*)(ws + WS_CQ); const bf16* CKV = (const bf16*)(ws + WS_CKV); const bf16* KRR = (const bf16*)(ws + WS_KRR);
    float* KR = (float*)(ws + WS_KR); float* RCQ = (float*)(ws + WS_RCQ); float* RCKV = (float*)(ws + WS_RCKV); float* SKR = (float*)(ws + WS_SKR); const float2* CS = (const float2*)(ws + WS_CS);
    const int d0 = (8 * lane) & 63;
    float gq[8], gk[8];
#pragma unroll
    for (int i = 0; i < 8; ++i) { gq[i] = I.g_qa[d0 + i] * QSCALE_A; gk[i] = I.g_ka[d0 + i]; }
    for (int m = gw; m < M; m += NGW) {
#pragma unroll
        for (int which = 0; which < 2; ++which) {
            bf16* P = (which == 0 ? QA : KA) + (size_t)m * 512 + 8 * lane;
            const v4u raw = *(const GAS v4u*)P; float v[8];
            v[0] = bflo(raw.x); v[1] = bfhi(raw.x); v[2] = bflo(raw.y); v[3] = bfhi(raw.y); v[4] = bflo(raw.z); v[5] = bfhi(raw.z); v[6] = bflo(raw.w); v[7] = bfhi(raw.w);
            float ss = 0.f;
#pragma unroll
            for (int i = 0; i < 8; ++i) ss += v[i] * v[i];
            ss += __shfl_xor(ss, 1); ss += __shfl_xor(ss, 2); ss += __shfl_xor(ss, 4);
            const float rstd = 1.f / sqrtf(ss * (1.f / 64.f) + EPS);
            v4u o;
            if (which == 0) { o.x = pk2(v[0] * rstd * gq[0], v[1] * rstd * gq[1]); o.y = pk2(v[2] * rstd * gq[2], v[3] * rstd * gq[3]); o.z = pk2(v[4] * rstd * gq[4], v[5] * rstd * gq[5]); o.w = pk2(v[6] * rstd * gq[6], v[7] * rstd * gq[7]); }
            else { o.x = pk2(v[0] * rstd * gk[0], v[1] * rstd * gk[1]); o.y = pk2(v[2] * rstd * gk[2], v[3] * rstd * gk[3]); o.z = pk2(v[4] * rstd * gk[4], v[5] * rstd * gk[5]); o.w = pk2(v[6] * rstd * gk[6], v[7] * rstd * gk[7]); }
            *(GAS v4u*)P = o;
        }
        { float ss = 0.f;
#pragma unroll
          for (int j = 0; j < 12; ++j) { const float c = bf2f(CQ[(size_t)m * 768 + j * 64 + lane]); ss += c * c; }
          ss = wave_sum(ss); if (lane == 0) RCQ[m] = 1.f / sqrtf(ss * (1.f / 768.f) + EPS); }
        { float ss = 0.f;
#pragma unroll
          for (int j = 0; j < 4; ++j) { const float c = bf2f(CKV[(size_t)m * 256 + j * 64 + lane]); ss += c * c; }
          ss = wave_sum(ss); if (lane == 0) RCKV[m] = 1.f / sqrtf(ss * (1.f / 256.f) + EPS); }
        { const int l = lane & 31; const float v = bf2f(KRR[(size_t)m * 32 + l]); float ss = lane < 32 ? v * v : 0.f; ss = wave_sum(ss);
          const float y = v * I.g_kb[64 + l]; const float p = __shfl_xor(y, 16); const float2 cs = CS[(size_t)m * 16 + (l & 15)];
          const float o = (l < 16) ? (y * cs.x - p * cs.y) : (y * cs.x + p * cs.y);
          if (lane < 32) KR[(size_t)m * 32 + l] = o; if (lane == 0) SKR[m] = ss; }
    }
}
__device__ __forceinline__ void e2_phase(Frame& F, const In& I, unsigned char* ws) {
    const int gw = F.vcu * NWAVES + F.wave, NGW = F.G * NWAVES, lane = F.lane;
    bf16* QB = (bf16*)(ws + WS_QB); const bf16* KVR = (const bf16*)(ws + WS_KVR); bf16* KBN = (bf16*)(ws + WS_KBN); bf16* KBR = (bf16*)(ws + WS_KBR); bf16* VB = (bf16*)(ws + WS_VB);
    const float* KR = (const float*)(ws + WS_KR); const float* RCQ = (const float*)(ws + WS_RCQ); const float* RCKV = (const float*)(ws + WS_RCKV); const float* SKR = (const float*)(ws + WS_SKR); const float2* CS = (const float2*)(ws + WS_CS);
    const int l = lane & 31;
    const float gq0 = I.g_qb[l], gq1 = I.g_qb[32 + l], gq2 = I.g_qb[64 + l], gkn = I.g_kb[lane];
    for (int m = gw; m < M; m += NGW) {
        const float rcq = RCQ[m], rckv = RCKV[m], skr = SKR[m]; const float2 cs = CS[(size_t)m * 16 + (l & 15)]; const float kr = KR[(size_t)m * 32 + l];
        for (int h = 0; h < 8; ++h) {
            bf16* q = QB + (size_t)m * 768 + 96 * h;
            const float v0 = bf2f(q[l]) * rcq, v1 = bf2f(q[32 + l]) * rcq, v2 = bf2f(q[64 + l]) * rcq;
            float ss = lane < 32 ? (v0 * v0 + v1 * v1 + v2 * v2) : 0.f; ss = wave_sum(ss);
            const float rstd = 1.f / sqrtf(ss * (1.f / 96.f) + EPS);
            const float y0 = v0 * rstd * gq0, y1 = v1 * rstd * gq1, y2 = v2 * rstd * gq2; const float p = __shfl_xor(y2, 16);
            const float r2 = (l < 16) ? (y2 * cs.x - p * cs.y) : (y2 * cs.x + p * cs.y);
            asm volatile("" ::: "memory");
            if (lane < 32) { q[l] = (bf16)f2bf(y0 * QSCALE_B); q[32 + l] = (bf16)f2bf(y1 * QSCALE_B); q[64 + l] = (bf16)f2bf(r2 * QSCALE_B); }
            const float kn = bf2f(KVR[(size_t)m * 1024 + 128 * h + lane]) * rckv, vv = bf2f(KVR[(size_t)m * 1024 + 128 * h + 64 + lane]) * rckv;
            const float sk = wave_sum(kn * kn) + skr; const float rk = 1.f / sqrtf(sk * (1.f / 96.f) + EPS);
            KBN[(size_t)m * 512 + 64 * h + lane] = (bf16)f2bf(kn * rk * gkn);
            if (lane < 32) KBR[(size_t)m * 256 + 32 * h + l] = (bf16)f2bf(kr * rk);
            VB[(size_t)m * 512 + 64 * h + lane] = (bf16)f2bf(vv);
        }
    }
}
__device__ __forceinline__ void e4_phase(Frame& F, const float* out, unsigned char* ws) {
    const int gw = F.vcu * NWAVES + F.wave, NGW = F.G * NWAVES;
    bf16* H1B = (bf16*)(ws + WS_H1B); float* RH = (float*)(ws + WS_RH);
    for (int m = gw; m < M; m += NGW) {
        const GAS f32x4* xr = (const GAS f32x4*)(out + (size_t)m * D) + F.lane;
        f32x4 v[4]; float s2 = 0.f;
#pragma unroll
        for (int j = 0; j < 4; ++j) { v[j] = xr[64 * j]; s2 += (v[j].x * v[j].x + v[j].y * v[j].y) + (v[j].z * v[j].z + v[j].w * v[j].w); }
        s2 = wave_sum(s2); if (F.lane == 0) RH[m] = 1.f / sqrtf(s2 * (1.f / D) + EPS);
        GAS unsigned long long* o8 = (GAS unsigned long long*)(H1B + (size_t)m * D) + F.lane;
#pragma unroll
        for (int j = 0; j < 4; ++j) o8[64 * j] = (unsigned long long)pk2(v[j].x, v[j].y) | ((unsigned long long)pk2(v[j].z, v[j].w) << 32);
    }
}
#define UNPK8(raw, dst, off) do { dst[(off) + 0] = bflo(raw.x); dst[(off) + 1] = bfhi(raw.x); dst[(off) + 2] = bflo(raw.y); dst[(off) + 3] = bfhi(raw.y); dst[(off) + 4] = bflo(raw.z); dst[(off) + 5] = bfhi(raw.z); dst[(off) + 6] = bflo(raw.w); dst[(off) + 7] = bfhi(raw.w); } while (0)
__device__ __forceinline__ float dot8(const v4u raw, const float* q) {
    return (bflo(raw.x) * q[0] + bfhi(raw.x) * q[1]) + (bflo(raw.y) * q[2] + bfhi(raw.y) * q[3]) + (bflo(raw.z) * q[4] + bfhi(raw.z) * q[5]) + (bflo(raw.w) * q[6] + bfhi(raw.w) * q[7]);
}
__device__ __forceinline__ void attn_naive_a(Frame& F, unsigned char* ws) {
    const int gt = (F.vcu * NWAVES + F.wave) * 64 + F.lane, NGT = F.G * NWAVES * 64;
    const bf16* QA = (const bf16*)(ws + WS_QA); const bf16* KA = (const bf16*)(ws + WS_KA); const bf16* VA = (const bf16*)(ws + WS_VA); bf16* MIX = (bf16*)(ws + WS_MIX);
    const float* BT = (const float*)(ws + WS_BIAS);
    for (int idx = gt; idx < HA * M; idx += NGT) {
        const int h = idx >> 14, m = idx & (M - 1), b = m >> 12, t = m & (SEQ - 1);
        float q[64], o[64];
#pragma unroll
        for (int c = 0; c < 8; ++c) { const v4u raw = *(const GAS v4u*)(QA + (size_t)m * 512 + 64 * h + 8 * c); UNPK8(raw, q, 8 * c); }
#pragma unroll
        for (int d = 0; d < 64; ++d) o[d] = 0.f;
        float mx = -INFINITY, l = 0.f;
        for (int br = 0; br < 3; ++br) {
            const int dil = br == 0 ? 1 : (br == 1 ? 4 : 16);
            for (int j = 0; j <= 128; ++j) {
                const int tk = t - dil * j; if (tk < 0) break;
                const size_t krow = (size_t)(b * SEQ + tk) * 512 + 64 * h;
                float s = BT[(br * 8 + h) * 132 + j];
#pragma unroll
                for (int c = 0; c < 8; ++c) { const v4u raw = *(const GAS v4u*)(KA + krow + 8 * c); s += dot8(raw, q + 8 * c); }
                const float mn = fmaxf(mx, s), cf = __builtin_amdgcn_exp2f(mx - mn), p = __builtin_amdgcn_exp2f(s - mn);
                l = l * cf + p; mx = mn;
#pragma unroll
                for (int c = 0; c < 8; ++c) { const v4u raw = *(const GAS v4u*)(VA + krow + 8 * c); float vv[8]; UNPK8(raw, vv, 0);
#pragma unroll
                    for (int i = 0; i < 8; ++i) o[8 * c + i] = o[8 * c + i] * cf + p * vv[i]; }
            }
        }
        const float il = 1.f / l;
#pragma unroll
        for (int c = 0; c < 8; ++c) { v4u w; w.x = pk2(o[8 * c] * il, o[8 * c + 1] * il); w.y = pk2(o[8 * c + 2] * il, o[8 * c + 3] * il); w.z = pk2(o[8 * c + 4] * il, o[8 * c + 5] * il); w.w = pk2(o[8 * c + 6] * il, o[8 * c + 7] * il);
            *(GAS v4u*)(MIX + (size_t)m * 1024 + 64 * h + 8 * c) = w; }
    }
}
__device__ __forceinline__ void attn_naive_b(Frame& F, unsigned char* ws) {
    const int gt = (F.vcu * NWAVES + F.wave) * 64 + F.lane, NGT = F.G * NWAVES * 64;
    const bf16* QB = (const bf16*)(ws + WS_QB); const bf16* KBN = (const bf16*)(ws + WS_KBN); const bf16* KBR = (const bf16*)(ws + WS_KBR); const bf16* VB = (const bf16*)(ws + WS_VB); bf16* MIX = (bf16*)(ws + WS_MIX);
    for (int idx = gt; idx < HB * M; idx += NGT) {
        const int h = idx >> 14, m = idx & (M - 1), b = m >> 12, t = m & (SEQ - 1);
        float q[96], o[64];
#pragma unroll
        for (int c = 0; c < 12; ++c) { const v4u raw = *(const GAS v4u*)(QB + (size_t)m * 768 + 96 * h + 8 * c); UNPK8(raw, q, 8 * c); }
#pragma unroll
        for (int d = 0; d < 64; ++d) o[d] = 0.f;
        float mx = -INFINITY, l = 0.f;
        for (int tk = 0; tk <= t; ++tk) {
            const size_t r = (size_t)(b * SEQ + tk);
            float s = 0.f;
#pragma unroll
            for (int c = 0; c < 8; ++c) { const v4u raw = *(const GAS v4u*)(KBN + r * 512 + 64 * h + 8 * c); s += dot8(raw, q + 8 * c); }
#pragma unroll
            for (int c = 0; c < 4; ++c) { const v4u raw = *(const GAS v4u*)(KBR + r * 256 + 32 * h + 8 * c); s += dot8(raw, q + 64 + 8 * c); }
            const float mn = fmaxf(mx, s), cf = __builtin_amdgcn_exp2f(mx - mn), p = __builtin_amdgcn_exp2f(s - mn);
            l = l * cf + p; mx = mn;
#pragma unroll
            for (int c = 0; c < 8; ++c) { const v4u raw = *(const GAS v4u*)(VB + r * 512 + 64 * h + 8 * c); float vv[8]; UNPK8(raw, vv, 0);
#pragma unroll
                for (int i = 0; i < 8; ++i) o[8 * c + i] = o[8 * c + i] * cf + p * vv[i]; }
        }
        const float il = 1.f / l;
#pragma unroll
        for (int c = 0; c < 8; ++c) { v4u w; w.x = pk2(o[8 * c] * il, o[8 * c + 1] * il); w.y = pk2(o[8 * c + 2] * il, o[8 * c + 3] * il); w.z = pk2(o[8 * c + 4] * il, o[8 * c + 5] * il); w.w = pk2(o[8 * c + 6] * il, o[8 * c + 7] * il);
            *(GAS v4u*)(MIX + (size_t)m * 1024 + 512 + 64 * h + 8 * c) = w; }
    }
}
constexpr int PER_PHASE = 10;
constexpr int N_LAUNCHES = MK_N_LAUNCHES;
struct Args { const void* in[17]; float* out; unsigned char* ws; int ph_lo, ph_hi, li, pad; };
__global__ void __launch_bounds__(NWAVES * 64, 2) fwd_kernel(Args args) {
    extern __shared__ __attribute__((aligned(16))) unsigned char lds[];
    Frame F;
    F.lds = (LAS unsigned char*)lds;
    F.MISC = (volatile LAS unsigned*)(F.lds + MISC_OFF);
    F.tid = threadIdx.x; F.lane = F.tid & 63; F.wave = __builtin_amdgcn_readfirstlane(F.tid >> 6);
    F.G = gridDim.x; { const int bx = blockIdx.x; F.vcu = (F.G % 8 == 0) ? (bx % 8) * (F.G / 8) + bx / 8 : bx; }
    unsigned char* ws = args.ws;
    F.ctl = (gu32*)(ws + WS_CTL);
    In I; I.x = (const float*)args.in[0]; I.pos = (const int*)args.in[1]; I.g_mix = (const float*)args.in[2]; I.w_in = (const float*)args.in[3]; I.g_qa = (const float*)args.in[4]; I.g_ka = (const float*)args.in[5];
    I.rel_bias = (const float*)args.in[6]; I.g_cq = (const float*)args.in[7]; I.g_ckv = (const float*)args.in[8]; I.w_uq = (const float*)args.in[9]; I.w_ukv = (const float*)args.in[10]; I.g_qb = (const float*)args.in[11];
    I.g_kb = (const float*)args.in[12]; I.w_o = (const float*)args.in[13]; I.g_ffn = (const float*)args.in[14]; I.w1 = (const float*)args.in[15]; I.w2 = (const float*)args.in[16];
    for (int u = F.tid; u < (LDS_BYTES - LDSCTL_OFF) / 4; u += NWAVES * 64) ((LAS unsigned*)(F.lds + LDSCTL_OFF))[u] = 0u;
    __syncthreads();
    XcdBarrier bar; bar.bar = (unsigned*)(F.ctl + CW_BAR); bar.x = 0; bar.st = nullptr;
    if (N_LAUNCHES != PER_PHASE) bar = xcd_barrier_post((unsigned*)(F.ctl + CW_BAR), F.MISC + 8);
#define GRID_BAR() do { if (N_LAUNCHES != PER_PHASE) xcd_barrier(bar); } while (0)
    const int lo = args.ph_lo, hi = args.ph_hi;
#define IN(k) (lo <= (k) && (k) < hi)
#define BOTH(k) (IN(k) && IN((k) + 1))
    bf16* XN = (bf16*)(ws + WS_XN);
    if (IN(0)) { p0_prologue(F, I, ws); if (BOTH(0)) GRID_BAR(); }
    if (IN(1)) {
        pg8::Gemm g{XN, (const bf16*)(ws + WS_WIN), M, NIN_PAD, D}; pg8::StaticOrder S; S.init(M, NIN_PAD, F.G, (int)blockIdx.x);
        pg8::EpiSplit E{(bf16*)(ws + WS_QA), (bf16*)(ws + WS_KA), (bf16*)(ws + WS_VA), (bf16*)(ws + WS_CQ), (bf16*)(ws + WS_CKV), (bf16*)(ws + WS_KRR)};
        pg8::gemm_phase<pg8::EpiSplit, pg8::StaticOrder, PG8_ALIGN, PG8_SP2>(F.lds + RING_OFF, g, S, E);
        if (BOTH(1)) GRID_BAR();
    }
    if (IN(2)) { e1_phase(F, I, ws); if (BOTH(2)) GRID_BAR(); }
    if (IN(3)) {
        { pg8::Gemm g{(const bf16*)(ws + WS_CQ), (const bf16*)(ws + WS_WUQ), M, 768, QLR}; pg8::StaticOrder S; S.init(M, 768, F.G, (int)blockIdx.x);
          pg8::EpiBf16P E{(bf16*)(ws + WS_QB), 768};
          pg8::gemm_phase<pg8::EpiBf16P, pg8::StaticOrder, PG8_ALIGN, PG8_SP2>(F.lds + RING_OFF, g, S, E); }
        { pg8::Gemm g{(const bf16*)(ws + WS_CKV), (const bf16*)(ws + WS_WUKV), M, 1024, KVLR}; pg8::StaticOrder S; S.init(M, 1024, F.G, (int)blockIdx.x);
          pg8::EpiBf16P E{(bf16*)(ws + WS_KVR), 1024};
          pg8::gemm_phase<pg8::EpiBf16P, pg8::StaticOrder, PG8_ALIGN, PG8_SP2>(F.lds + RING_OFF, g, S, E); }
        if (BOTH(3)) GRID_BAR();
    }
    if (IN(4)) { e2_phase(F, I, ws); if (BOTH(4)) GRID_BAR(); }
    if (IN(5)) { attn_naive_a(F, ws); attn_naive_b(F, ws); if (BOTH(5)) GRID_BAR(); }
    if (IN(6)) {
        pg8::Gemm g{(const bf16*)(ws + WS_MIX), (const bf16*)(ws + WS_WO), M, D, D}; pg8::StaticOrder S; S.init(M, D, F.G, (int)blockIdx.x);
        pg8::EpiF32Res E{I.x, args.out, D};
        pg8::gemm_phase<pg8::EpiF32Res, pg8::StaticOrder, PG8_ALIGN, PG8_SP2>(F.lds + RING_OFF, g, S, E);
        if (BOTH(6)) GRID_BAR();
    }
    if (IN(7)) { e4_phase(F, args.out, ws); if (BOTH(7)) GRID_BAR(); }
    if (IN(8)) {
        pg8::Gemm g{(const bf16*)(ws + WS_H1B), (const bf16*)(ws + WS_W1), M, FF, D}; pg8::StaticOrder S; S.init(M, FF, F.G, (int)blockIdx.x);
        pg8::EpiRelu2 E{(const float*)(ws + WS_RH), (bf16*)(ws + WS_HID), FF};
        pg8::gemm_phase<pg8::EpiRelu2, pg8::StaticOrder, PG8_ALIGN, PG8_SP2>(F.lds + RING_OFF, g, S, E);
        if (BOTH(8)) GRID_BAR();
    }
    if (IN(9)) {
        pg8::Gemm g{(const bf16*)(ws + WS_HID), (const bf16*)(ws + WS_W2), M, D, FF}; pg8::StaticOrder S; S.init(M, D, F.G, (int)blockIdx.x);
        pg8::EpiF32Res E{args.out, args.out, D};
        pg8::gemm_phase<pg8::EpiF32Res, pg8::StaticOrder, PG8_ALIGN, PG8_SP2>(F.lds + RING_OFF, g, S, E);
    }
#undef IN
#undef BOTH
}

extern "C" void kernel_launch(void* const* d_in, const int* in_sizes, int n_in, void* d_out, int out_size, void* d_ws, size_t ws_size, hipStream_t stream) {
    static int grid = 0;
    if (grid == 0) {
        if (n_in != 17 || out_size != M * D || ws_size < WS_END) { fprintf(stderr, "kernel_launch: unexpected problem shape (n_in %d out %d ws %zu)\n", n_in, out_size, ws_size); grid = -1; return; }
        int dev = 0, cus = 0, per_cu = 0;
        if (hipGetDevice(&dev) != hipSuccess || hipDeviceGetAttribute(&cus, hipDeviceAttributeMultiprocessorCount, dev) != hipSuccess) { grid = -1; return; }
        if (hipFuncSetAttribute((const void*)fwd_kernel, hipFuncAttributeMaxDynamicSharedMemorySize, LDS_BYTES) != hipSuccess) { fprintf(stderr, "kernel_launch: hipFuncSetAttribute failed\n"); grid = -1; return; }
        if (hipOccupancyMaxActiveBlocksPerMultiprocessor(&per_cu, (const void*)fwd_kernel, NWAVES * 64, LDS_BYTES) != hipSuccess || per_cu < 1) { fprintf(stderr, "kernel_launch: occupancy query says %d\n", per_cu); (void)hipGetLastError(); grid = -1; return; }
        grid = cus;
    }
    if (grid < 0) return;
    (void)hipMemsetAsync((char*)d_ws + WS_CTL, 0, CTL_ZERO_BYTES, stream);
    Args a{};
    for (int i = 0; i < 17; ++i) a.in[i] = d_in[i];
    a.out = (float*)d_out; a.ws = (unsigned char*)d_ws;
    if (N_LAUNCHES == 1) { a.ph_lo = 0; a.ph_hi = PER_PHASE; a.li = 0; hipLaunchKernelGGL(fwd_kernel, dim3(grid), dim3(NWAVES * 64), LDS_BYTES, stream, a); }
    else for (int li = 0; li < PER_PHASE; ++li) { a.ph_lo = li; a.ph_hi = li + 1; a.li = li; hipLaunchKernelGGL(fwd_kernel, dim3(grid), dim3(NWAVES * 64), LDS_BYTES, stream, a); }
}
```

```cpp
#include <hip/hip_runtime.h>
#include <cstdio>
#include <cstdint>
namespace pg8 {
#define PG8_LAS __attribute__((address_space(3)))
typedef unsigned short bf16_t;
typedef short bf16x8 __attribute__((ext_vector_type(8)));
typedef float f32x4 __attribute__((ext_vector_type(4)));
typedef unsigned u32x4 __attribute__((ext_vector_type(4)));
constexpr int BM = 256, BK = 64, HALF = 128, HTB = HALF * BK * 2  , STAGE_BYTES = 8 * HTB, NXCD = 8, WGM = 8;

__host__ __device__ __forceinline__ int lds_byte(int r, int c) { const int st = (r >> 4) * 2 + (c >> 5), rr = r & 15, cc = c & 31, ob = rr * 64 + cc * 2; return st * 1024 + (ob ^ (((ob >> 9) & 1) << 5)); }
__host__ __device__ __forceinline__ void stage_rc(int b, int& R, int& C) { const int st = b / 1024, sb = b % 1024, swz = sb ^ (((sb >> 9) & 1) << 5); R = (st >> 1) * 16 + swz / 64; C = (st & 1) * 32 + (swz % 64) / 2; }
__host__ __device__ __forceinline__ int perm32(int rho) { const int n = rho >> 4, i = rho & 15; return 8 * (i >> 2) + 4 * n + (i & 3); }

struct Unit { int pm, pn; };
struct Gemm { const bf16_t* A; const bf16_t* Bt; int M, N, K; };

struct StaticOrder {
    int nM, nN, nwg, G, c;
    __host__ __device__ void init(int M, int N, int G_, int c_) { nM = M / BM; nN = N / BM; nwg = nM * nN; G = G_; c = c_; }
    __host__ __device__ bool next(int i, Unit& u) const {
        const long L = (long)i * G + c; if (L >= nwg) return false;
        int wgid = (int)L; { const int q = nwg / NXCD, r = nwg % NXCD, xcd = wgid % NXCD, off = wgid / NXCD; wgid = (xcd < r ? xcd * (q + 1) : r * (q + 1) + (xcd - r) * q) + off; }
        const int nig = WGM * nN, gid = wgid / nig, fm = gid * WGM, gsz = (nM - fm) < WGM ? (nM - fm) : WGM;
        u.pm = fm + ((wgid % nig) % gsz); u.pn = (wgid % nig) / gsz; return true;
    }
    __device__ __forceinline__ void a_ready(const Unit&) const {}
    __device__ __forceinline__ void done(const Unit&) const {}
};

__device__ __forceinline__ unsigned cvt_pk_bf16(float lo, float hi) { unsigned r; asm volatile("v_cvt_pk_bf16_f32 %0, %1, %2" : "=v"(r) : "v"(lo), "v"(hi)); return r; }
__device__ __forceinline__ u32x4 pack8(const f32x4 v0, const f32x4 v1) { u32x4 w; w.x = cvt_pk_bf16(v0[0], v0[1]); w.y = cvt_pk_bf16(v0[2], v0[3]); w.z = cvt_pk_bf16(v1[0], v1[1]); w.w = cvt_pk_bf16(v1[2], v1[3]); return w; }

struct EpiInProj {
    static constexpr bool PERM = true, AFTER_DRAIN = false;
    bf16_t *QA, *KA, *VA, *CQ, *CKV; float *KR, *SSQ_CQ, *SSQ_CKV, *SKR; const float *g_qa, *g_ka, *g_kb; const float2* CS; float qscale;
    __device__ __forceinline__ void operator()(const f32x4 (&acc)[2][2][4][2], const Unit& u, int wr, int wc, int fr_, int fq_) const {
        int fr = fr_, fq = fq_; asm volatile("" : "+v"(fr), "+v"(fq));
        const int pn = u.pn; const int row0 = u.pm * BM + wr * 64 + fr;
        if (pn < 4) {
            const bool isq = pn < 2; bf16_t* base = (isq ? QA : KA) + 256 * (pn & 1) + 64 * wc + 8 * fq; const float* g = (isq ? g_qa : g_ka) + 8 * fq; const float sc = isq ? qscale : 1.0f;
            f32x4 gv[2][2];
#pragma unroll
            for (int bj = 0; bj < 2; ++bj)
#pragma unroll
                for (int n = 0; n < 2; ++n) gv[bj][n] = *(const f32x4*)(g + 32 * bj + 4 * n) * sc;
#pragma unroll
            for (int ai = 0; ai < 2; ++ai)
#pragma unroll
                for (int m = 0; m < 4; ++m) { float ss = 0.f;
#pragma unroll
                    for (int bj = 0; bj < 2; ++bj)
#pragma unroll
                        for (int n = 0; n < 2; ++n) { const f32x4 x = acc[ai][bj][m][n]; ss += (x[0] * x[0] + x[1] * x[1]) + (x[2] * x[2] + x[3] * x[3]); }
                    ss += __shfl_xor(ss, 16); ss += __shfl_xor(ss, 32);
                    const float rstd = 1.0f / sqrtf(ss * (1.0f / 64.0f) + 1e-6f);
                    bf16_t* rowp = base + (size_t)(row0 + ai * HALF + m * 16) * 512;
#pragma unroll
                    for (int bj = 0; bj < 2; ++bj) *(u32x4*)(rowp + 32 * bj) = pack8(acc[ai][bj][m][0] * rstd * gv[bj][0], acc[ai][bj][m][1] * rstd * gv[bj][1]); }
        } else if (pn < 10) {
            bf16_t* base; int ldc; float* ssq = nullptr; int sld = 0;
            if (pn < 6) { base = VA + 256 * (pn - 4); ldc = 512; } else if (pn < 9) { base = CQ + 256 * (pn - 6); ldc = 768; ssq = SSQ_CQ + 4 * (pn - 6) + wc; sld = 12; } else { base = CKV; ldc = 256; ssq = SSQ_CKV + wc; sld = 4; }
            base += 64 * wc + 8 * fq;
#pragma unroll
            for (int ai = 0; ai < 2; ++ai)
#pragma unroll
                for (int m = 0; m < 4; ++m) { const int row = row0 + ai * HALF + m * 16; bf16_t* rowp = base + (size_t)row * ldc;
#pragma unroll
                    for (int bj = 0; bj < 2; ++bj) *(u32x4*)(rowp + 32 * bj) = pack8(acc[ai][bj][m][0], acc[ai][bj][m][1]);
                    if (ssq) { float ss = 0.f;
#pragma unroll
                        for (int bj = 0; bj < 2; ++bj)
#pragma unroll
                            for (int n = 0; n < 2; ++n) { const f32x4 x = acc[ai][bj][m][n]; ss += (x[0] * x[0] + x[1] * x[1]) + (x[2] * x[2] + x[3] * x[3]); }
                        ss += __shfl_xor(ss, 16); ss += __shfl_xor(ss, 32);
                        if (fq == 0) ssq[(size_t)row * sld] = ss; } }
        } else if (wc == 0) {
            const int d0 = 8 * fq;
#pragma unroll
            for (int ai = 0; ai < 2; ++ai)
#pragma unroll
                for (int m = 0; m < 4; ++m) { const int row = row0 + ai * HALF + m * 16; float ss = 0.f;
#pragma unroll
                    for (int bj = 0; bj < 2; ++bj)
#pragma unroll
                        for (int n = 0; n < 2; ++n) { const f32x4 x = acc[ai][bj][m][n]; ss += (x[0] * x[0] + x[1] * x[1]) + (x[2] * x[2] + x[3] * x[3]); }
                    if (fq >= 2) ss = 0.f;
                    ss += __shfl_xor(ss, 16); ss += __shfl_xor(ss, 32);
                    if (fq == 0) SKR[row] = ss;
                    if (fq < 2) {
#pragma unroll
                        for (int n = 0; n < 2; ++n) { const f32x4 g1 = *(const f32x4*)(g_kb + 64 + d0 + 4 * n), g2 = *(const f32x4*)(g_kb + 80 + d0 + 4 * n);
                            const f32x4 y1 = acc[ai][0][m][n] * g1, y2 = acc[ai][1][m][n] * g2; f32x4 o1, o2;
#pragma unroll
                            for (int i = 0; i < 4; ++i) { const float2 cs = CS[(size_t)row * 16 + d0 + 4 * n + i]; o1[i] = y1[i] * cs.x - y2[i] * cs.y; o2[i] = y2[i] * cs.x + y1[i] * cs.y; }
                            *(f32x4*)(KR + (size_t)row * 32 + d0 + 4 * n) = o1; *(f32x4*)(KR + (size_t)row * 32 + 16 + d0 + 4 * n) = o2; } } }
        }
    }
};
struct EpiWo {
    static constexpr bool PERM = true, AFTER_DRAIN = false;
    const float* base; float* out; bf16_t* H1B; float* SSQ; int ldc;
    __device__ __forceinline__ void operator()(const f32x4 (&acc)[2][2][4][2], const Unit& u, int wr, int wc, int fr_, int fq_) const {
        int fr = fr_, fq = fq_; asm volatile("" : "+v"(fr), "+v"(fq));
        const int row0 = u.pm * BM + wr * 64 + fr, col0 = u.pn * BM + wc * 32 + 8 * fq;
#pragma unroll
        for (int ai = 0; ai < 2; ++ai) {
            f32x4 xb[4][2][2];
#pragma unroll
            for (int m = 0; m < 4; ++m)
#pragma unroll
                for (int bj = 0; bj < 2; ++bj) { const float* p = base + (size_t)(row0 + ai * HALF + m * 16) * ldc + col0 + bj * HALF; xb[m][bj][0] = *(const f32x4*)p; xb[m][bj][1] = *(const f32x4*)(p + 4); }
            asm volatile("" ::: "memory");
#pragma unroll
            for (int m = 0; m < 4; ++m) { const int row = row0 + ai * HALF + m * 16; const size_t off = (size_t)row * ldc + col0; float ss = 0.f;
#pragma unroll
                for (int bj = 0; bj < 2; ++bj) { const f32x4 h0 = xb[m][bj][0] + acc[ai][bj][m][0], h1 = xb[m][bj][1] + acc[ai][bj][m][1];
                    *(u32x4*)(H1B + off + bj * HALF) = pack8(h0, h1);
                    ss += (h0[0] * h0[0] + h0[1] * h0[1]) + (h0[2] * h0[2] + h0[3] * h0[3]) + (h1[0] * h1[0] + h1[1] * h1[1]) + (h1[2] * h1[2] + h1[3] * h1[3]); }
                ss += __shfl_xor(ss, 16); ss += __shfl_xor(ss, 32);
                if (fq == 0) SSQ[(size_t)row * 16 + 4 * u.pn + wc] = ss; }
            asm volatile("" ::: "memory");
        }
    }
};
template <int NS, int KD> __device__ __forceinline__ float rstd_slots(const float* ssq, int row) {
    const f32x4* sp = (const f32x4*)(ssq + (size_t)row * NS); f32x4 s4 = sp[0];
#pragma unroll
    for (int i = 1; i < NS / 4; ++i) s4 += sp[i];
    return 1.0f / sqrtf(((s4[0] + s4[1]) + (s4[2] + s4[3])) * (1.0f / (float)KD) + 1e-6f);
}
template <int NS, int KD> __device__ __forceinline__ void rstd_rows8(const float* ssq, int row0, int fr, int fq, float (&rs)[2][4]) {
    float own[2];
#pragma unroll
    for (int ai = 0; ai < 2; ++ai) own[ai] = rstd_slots<NS, KD>(ssq, row0 + ai * HALF + fq * 16);
    const int l15 = fr;
#pragma unroll
    for (int ai = 0; ai < 2; ++ai)
#pragma unroll
        for (int m = 0; m < 4; ++m) rs[ai][m] = __shfl(own[ai], l15 + 16 * m);
}
template <int NS, int KD> struct EpiRowScale {
    static constexpr bool PERM = true, AFTER_DRAIN = false;
    const float* ssq; bf16_t* O; int ldc;
    __device__ __forceinline__ void operator()(const f32x4 (&acc)[2][2][4][2], const Unit& u, int wr, int wc, int fr_, int fq_) const {
        int fr = fr_, fq = fq_; asm volatile("" : "+v"(fr), "+v"(fq));
        const int row0 = u.pm * BM + wr * 64 + fr, col0 = u.pn * BM + wc * 32 + 8 * fq;
        float rs[2][4]; rstd_rows8<NS, KD>(ssq, row0, fr, fq, rs);
#pragma unroll
        for (int ai = 0; ai < 2; ++ai)
#pragma unroll
            for (int m = 0; m < 4; ++m) { const int row = row0 + ai * HALF + m * 16; const float s = rs[ai][m]; bf16_t* rowp = O + (size_t)row * ldc + col0;
#pragma unroll
                for (int bj = 0; bj < 2; ++bj) *(u32x4*)(rowp + bj * HALF) = pack8(acc[ai][bj][m][0] * s, acc[ai][bj][m][1] * s); }
    }
};
struct EpiKV {
    static constexpr bool PERM = true, AFTER_DRAIN = false;
    const float *SSQ_CKV, *SKR, *KR, *g_kb; bf16_t *KBN, *KBR, *VB;
    __device__ __forceinline__ void operator()(const f32x4 (&acc)[2][2][4][2], const Unit& u, int wr, int wc, int fr_, int fq_) const {
        int fr = fr_, fq = fq_; asm volatile("" : "+v"(fr), "+v"(fq));
        const int row0 = u.pm * BM + wr * 64 + fr, h = 2 * u.pn + (wc >> 1);
        float rs_own[2], skr_own[2];
#pragma unroll
        for (int ai = 0; ai < 2; ++ai) { rs_own[ai] = rstd_slots<4, 256>(SSQ_CKV, row0 + ai * HALF + fq * 16); skr_own[ai] = SKR[row0 + ai * HALF + fq * 16]; }
        if (wc & 1) {
#pragma unroll
            for (int ai = 0; ai < 2; ++ai)
#pragma unroll
                for (int m = 0; m < 4; ++m) { const int row = row0 + ai * HALF + m * 16; const float s = __shfl(rs_own[ai], fr + 16 * m); bf16_t* rowp = VB + (size_t)row * 512 + 64 * h + 8 * fq;
#pragma unroll
                    for (int bj = 0; bj < 2; ++bj) *(u32x4*)(rowp + 32 * bj) = pack8(acc[ai][bj][m][0] * s, acc[ai][bj][m][1] * s); }
        } else {
            f32x4 gk[2][2];
#pragma unroll
            for (int bj = 0; bj < 2; ++bj) { gk[bj][0] = *(const f32x4*)(g_kb + 32 * bj + 8 * fq); gk[bj][1] = *(const f32x4*)(g_kb + 32 * bj + 8 * fq + 4); }
#pragma unroll
            for (int ai = 0; ai < 2; ++ai) {
              f32x4 kr[4][2];
#pragma unroll
              for (int m = 0; m < 4; ++m) { const float* p = KR + (size_t)(row0 + ai * HALF + m * 16) * 32 + 8 * fq; kr[m][0] = *(const f32x4*)p; kr[m][1] = *(const f32x4*)(p + 4); }
              asm volatile("" ::: "memory");
#pragma unroll
                for (int m = 0; m < 4; ++m) { const int row = row0 + ai * HALF + m * 16; const float s = __shfl(rs_own[ai], fr + 16 * m), skr = __shfl(skr_own[ai], fr + 16 * m); float ss = 0.f;
#pragma unroll
                    for (int bj = 0; bj < 2; ++bj)
#pragma unroll
                        for (int n = 0; n < 2; ++n) { const f32x4 x = acc[ai][bj][m][n]; ss += (x[0] * x[0] + x[1] * x[1]) + (x[2] * x[2] + x[3] * x[3]); }
                    ss += __shfl_xor(ss, 16); ss += __shfl_xor(ss, 32);
                    const float rk = 1.0f / sqrtf((ss * s * s + skr) * (1.0f / 96.0f) + 1e-6f), sr = s * rk;
                    bf16_t* rowp = KBN + (size_t)row * 512 + 64 * h + 8 * fq;
#pragma unroll
                    for (int bj = 0; bj < 2; ++bj) *(u32x4*)(rowp + 32 * bj) = pack8(acc[ai][bj][m][0] * sr * gk[bj][0], acc[ai][bj][m][1] * sr * gk[bj][1]);
                    *(u32x4*)(KBR + (size_t)row * 256 + 32 * h + 8 * fq) = pack8(kr[m][0] * rk, kr[m][1] * rk); }
              asm volatile("" ::: "memory"); }
        }
    }
};
struct EpiF32ResB {
    static constexpr bool PERM = true, AFTER_DRAIN = false;
    const bf16_t* baseb; float* out; int ldc;
    __device__ __forceinline__ void operator()(const f32x4 (&acc)[2][2][4][2], const Unit& u, int wr, int wc, int fr_, int fq_) const {
        int fr = fr_, fq = fq_; asm volatile("" : "+v"(fr), "+v"(fq));
        const int row0 = u.pm * BM + wr * 64 + fr, col0 = u.pn * BM + wc * 32 + 8 * fq;
        u32x4 bb[2][4][2];
#pragma unroll
        for (int ai = 0; ai < 2; ++ai)
#pragma unroll
            for (int m = 0; m < 4; ++m)
#pragma unroll
                for (int bj = 0; bj < 2; ++bj) bb[ai][m][bj] = *(const u32x4*)(baseb + (size_t)(row0 + ai * HALF + m * 16) * ldc + col0 + bj * HALF);
        asm volatile("" ::: "memory");
#pragma unroll
        for (int ai = 0; ai < 2; ++ai)
#pragma unroll
            for (int m = 0; m < 4; ++m) { const size_t off = (size_t)(row0 + ai * HALF + m * 16) * ldc + col0;
#pragma unroll
                for (int bj = 0; bj < 2; ++bj) { const u32x4 b = bb[ai][m][bj];
                    f32x4 b0, b1; b0[0] = __uint_as_float(b.x << 16); b0[1] = __uint_as_float(b.x & 0xffff0000u); b0[2] = __uint_as_float(b.y << 16); b0[3] = __uint_as_float(b.y & 0xffff0000u);
                    b1[0] = __uint_as_float(b.z << 16); b1[1] = __uint_as_float(b.z & 0xffff0000u); b1[2] = __uint_as_float(b.w << 16); b1[3] = __uint_as_float(b.w & 0xffff0000u);
                    *(f32x4*)(out + off + bj * HALF) = b0 + acc[ai][bj][m][0]; *(f32x4*)(out + off + bj * HALF + 4) = b1 + acc[ai][bj][m][1]; } }
    }
};
struct EpiRelu2 {
    static constexpr bool PERM = true, AFTER_DRAIN = false;
    const float* ssq; bf16_t* O; int ldc;
    __device__ __forceinline__ void operator()(const f32x4 (&acc)[2][2][4][2], const Unit& u, int wr, int wc, int fr_, int fq_) const {
        int fr = fr_, fq = fq_; asm volatile("" : "+v"(fr), "+v"(fq));
        const int row0 = u.pm * BM + wr * 64 + fr, col0 = u.pn * BM + wc * 64 + 8 * fq;
        float rs[2][4]; rstd_rows8<16, 1024>(ssq, row0, fr, fq, rs);
#pragma unroll
        for (int ai = 0; ai < 2; ++ai)
#pragma unroll
            for (int m = 0; m < 4; ++m) { const int row = row0 + ai * HALF + m * 16; const float s = rs[ai][m]; bf16_t* rowp = O + (size_t)row * ldc + col0;
#pragma unroll
                for (int bj = 0; bj < 2; ++bj) { f32x4 v0 = acc[ai][bj][m][0] * s, v1 = acc[ai][bj][m][1] * s;
#pragma unroll
                    for (int i = 0; i < 4; ++i) { const float a = fmaxf(v0[i], 0.f), b = fmaxf(v1[i], 0.f); v0[i] = a * a; v1[i] = b * b; }
                    *(u32x4*)(rowp + bj * 32) = pack8(v0, v1); } }
    }
};
template <class Epi, class Sched, bool ALIGN_EPI = false, bool SP2 = false>
__device__ __forceinline__ void gemm_phase(PG8_LAS unsigned char* lds, const Gemm g, const Sched& S, const Epi& E) {
    int tid_ = threadIdx.x; asm volatile("" : "+v"(tid_));
    const int tid = tid_, wid = __builtin_amdgcn_readfirstlane(tid >> 6), lane = tid & 63, wr = wid >> 2, wc = wid & 3, fr = lane & 15, fq = lane >> 4;
    const int K = g.K, nt = K / BK;
    unsigned voffA[2], voffB[2];
#pragma unroll
    for (int i = 0; i < 2; ++i) { int R, C; stage_rc(tid * 16 + i * 8192, R, C); const int Rb = Epi::PERM ? ((R & ~31) + perm32(R & 31)) : R;
        voffA[i] = (unsigned)(R * K + C) * 2u; voffB[i] = (unsigned)(Rb * K + C) * 2u; }
    const size_t kstep = (size_t)(BK * 2);
    const size_t hstep = (size_t)HALF * K * 2;
    const size_t tstep = 2 * hstep;
    const unsigned ldsw = (unsigned)wid * 1024u;
    const int aoff = lds_byte(wr * 64 + fr, fq * 8), boff = lds_byte(wc * 32 + fr, fq * 8);
#define PG8_SA(b, h) (((b) * 2 + (h)) * HTB)
#define PG8_SB(b, h) ((4 + (b) * 2 + (h)) * HTB)
#define PG8_STAGE(bufoff, gbase, voff) do { _Pragma("unroll") for (int _i = 0; _i < 2; ++_i) \
        __builtin_amdgcn_global_load_lds((const unsigned*)((const char*)(gbase) + (voff)[_i]), (PG8_LAS unsigned*)(lds + (bufoff) + ldsw + _i * 8192), 16, 0, 0); } while (0)
#define PG8_LDA(dst, b, h) do { _Pragma("unroll") for (int m = 0; m < 4; ++m) _Pragma("unroll") for (int k = 0; k < 2; ++k) dst[m][k] = *(const PG8_LAS bf16x8*)(lds + PG8_SA(b, h) + aoff + m * 2048 + k * 1024); } while (0)
#define PG8_LDB(dst, b, h) do { _Pragma("unroll") for (int n = 0; n < 2; ++n) _Pragma("unroll") for (int k = 0; k < 2; ++k) dst[n][k] = *(const PG8_LAS bf16x8*)(lds + PG8_SB(b, h) + boff + n * 2048 + k * 1024); } while (0)
#define PG8_MMA(ai, bj, At, Bt) do { __builtin_amdgcn_s_setprio(1); _Pragma("unroll") for (int m = 0; m < 4; ++m) _Pragma("unroll") for (int n = 0; n < 2; ++n) _Pragma("unroll") for (int k = 0; k < 2; ++k) \
        acc[ai][bj][m][n] = __builtin_amdgcn_mfma_f32_16x16x32_bf16(Bt[n][k], At[m][k], acc[ai][bj][m][n], 0, 0, 0); __builtin_amdgcn_s_setprio(0); } while (0)
#define PG8_WAIT_V(n) asm volatile("s_waitcnt vmcnt(" #n ")" ::: "memory")
#define PG8_WAIT_L(n) asm volatile("s_waitcnt lgkmcnt(" #n ")" ::: "memory")
#define PG8_BAR __builtin_amdgcn_s_barrier()
#define PG8_SCHED __builtin_amdgcn_sched_barrier(0)
    Unit cur, nxt; int ui = 0;
    if (!S.next(0, cur)) return;
    f32x4 acc[2][2][4][2];
#pragma unroll
    for (int a = 0; a < 2; ++a)
#pragma unroll
        for (int b = 0; b < 2; ++b)
#pragma unroll
            for (int m = 0; m < 4; ++m)
#pragma unroll
                for (int n = 0; n < 2; ++n) acc[a][b][m][n] = (f32x4){0.f, 0.f, 0.f, 0.f};
    bf16x8 At[4][2], B0[2][2], B1[2][2];
    const char* cA = (const char*)g.A + (size_t)cur.pm * tstep; const char* cB = (const char*)g.Bt + (size_t)cur.pn * tstep;
    S.a_ready(cur);
    if constexpr (SP2) {
        PG8_STAGE(PG8_SB(0, 0), cB, voffB); PG8_STAGE(PG8_SB(0, 1), cB + hstep, voffB); PG8_STAGE(PG8_SA(0, 0), cA, voffA); PG8_STAGE(PG8_SA(0, 1), cA + hstep, voffA);
        if (wr == 1) PG8_BAR;
        PG8_WAIT_V(2); PG8_BAR;
        PG8_STAGE(PG8_SB(1, 0), cB + kstep, voffB); PG8_STAGE(PG8_SA(1, 0), cA + kstep, voffA); PG8_STAGE(PG8_SB(1, 1), cB + hstep + kstep, voffB);
        PG8_WAIT_V(6); PG8_BAR;
    } else {
        PG8_STAGE(PG8_SB(0, 0), cB, voffB); PG8_STAGE(PG8_SA(0, 0), cA, voffA); PG8_STAGE(PG8_SB(0, 1), cB + hstep, voffB); PG8_STAGE(PG8_SA(0, 1), cA + hstep, voffA);
        if (wr == 1) PG8_BAR;
        PG8_WAIT_V(4); PG8_BAR;
        PG8_STAGE(PG8_SB(1, 0), cB + kstep, voffB); PG8_STAGE(PG8_SA(1, 0), cA + kstep, voffA); PG8_STAGE(PG8_SB(1, 1), cB + hstep + kstep, voffB);
        PG8_WAIT_V(6); PG8_BAR;
    }
    for (;;) {
        const bool has_next = S.next(ui + 1, nxt);
        const char* nA = has_next ? (const char*)g.A + (size_t)nxt.pm * tstep : cA; const char* nB = has_next ? (const char*)g.Bt + (size_t)nxt.pn * tstep : cB;
        for (int t = 0; t < nt; t += 2) {
            const bool last = (t == nt - 2);
            const char* a1 = cA + (size_t)(t + 1) * kstep;
            const char* a2 = last ? nA : cA + (size_t)(t + 2) * kstep; const char* b2 = last ? nB : cB + (size_t)(t + 2) * kstep;
            const char* a3 = a2 + kstep; const char* b3 = b2 + kstep;
            if (last && has_next) S.a_ready(nxt);
            if constexpr (SP2) {
            PG8_LDB(B0, 0, 0); PG8_LDB(B1, 0, 1); PG8_SCHED; PG8_LDA(At, 0, 0); PG8_STAGE(PG8_SA(1, 1), a1 + hstep, voffA);
            PG8_WAIT_V(8); PG8_WAIT_L(0); PG8_BAR; PG8_MMA(0, 0, At, B0); PG8_MMA(0, 1, At, B1); PG8_BAR; PG8_SCHED;
            PG8_LDA(At, 0, 1); PG8_STAGE(PG8_SB(0, 0), b2, voffB); PG8_STAGE(PG8_SB(0, 1), b2 + hstep, voffB); PG8_STAGE(PG8_SA(0, 0), a2, voffA);
            PG8_WAIT_V(8); PG8_WAIT_L(0); PG8_BAR; PG8_MMA(1, 0, At, B0); PG8_MMA(1, 1, At, B1); PG8_BAR; PG8_SCHED;
            PG8_LDB(B0, 1, 0); PG8_LDB(B1, 1, 1); PG8_SCHED; PG8_LDA(At, 1, 0); PG8_STAGE(PG8_SA(0, 1), a2 + hstep, voffA);
            PG8_WAIT_V(8); PG8_WAIT_L(0); PG8_BAR; PG8_MMA(0, 0, At, B0); PG8_MMA(0, 1, At, B1); PG8_BAR; PG8_SCHED;
            PG8_LDA(At, 1, 1); PG8_STAGE(PG8_SB(1, 0), b3, voffB); PG8_STAGE(PG8_SB(1, 1), b3 + hstep, voffB); PG8_STAGE(PG8_SA(1, 0), a3, voffA);
            PG8_WAIT_V(8); PG8_WAIT_L(0); PG8_BAR; PG8_MMA(1, 0, At, B0); PG8_MMA(1, 1, At, B1); PG8_BAR; PG8_SCHED;
            } else {
            PG8_LDB(B0, 0, 0); PG8_SCHED; PG8_LDA(At, 0, 0); PG8_STAGE(PG8_SA(1, 1), a1 + hstep, voffA);
            PG8_WAIT_L(8); PG8_BAR; PG8_WAIT_L(0); PG8_MMA(0, 0, At, B0); PG8_BAR; PG8_SCHED;
            PG8_LDB(B1, 0, 1); PG8_STAGE(PG8_SB(0, 0), b2, voffB);
            PG8_BAR; PG8_WAIT_L(0); PG8_MMA(0, 1, At, B1); PG8_BAR;
            PG8_LDA(At, 0, 1); PG8_STAGE(PG8_SA(0, 0), a2, voffA);
            PG8_BAR; PG8_WAIT_L(0); PG8_MMA(1, 0, At, B0); PG8_BAR; PG8_SCHED;
            PG8_STAGE(PG8_SB(0, 1), b2 + hstep, voffB);
            PG8_WAIT_V(6); PG8_BAR; PG8_MMA(1, 1, At, B1); PG8_BAR;
            PG8_LDB(B0, 1, 0); PG8_SCHED; PG8_LDA(At, 1, 0); PG8_STAGE(PG8_SA(0, 1), a2 + hstep, voffA);
            PG8_WAIT_L(8); PG8_BAR; PG8_WAIT_L(0); PG8_MMA(0, 0, At, B0); PG8_BAR; PG8_SCHED;
            PG8_LDB(B1, 1, 1); PG8_STAGE(PG8_SB(1, 0), b3, voffB);
            PG8_BAR; PG8_WAIT_L(0); PG8_MMA(0, 1, At, B1); PG8_BAR;
            PG8_LDA(At, 1, 1); PG8_STAGE(PG8_SA(1, 0), a3, voffA);
            PG8_BAR; PG8_WAIT_L(0); PG8_MMA(1, 0, At, B0); PG8_BAR; PG8_SCHED;
            PG8_STAGE(PG8_SB(1, 1), b3 + hstep, voffB);
            PG8_WAIT_V(6); PG8_BAR; PG8_MMA(1, 1, At, B1); PG8_BAR;
            }
        }
        if constexpr (ALIGN_EPI) { if (wr == 0) PG8_BAR; }
        if constexpr (!Epi::AFTER_DRAIN) { E(acc, cur, wr, wc, fr, fq); S.done(cur); }
        if (!has_next) break;
#pragma unroll
        for (int a = 0; a < 2; ++a)
#pragma unroll
            for (int b = 0; b < 2; ++b)
#pragma unroll
                for (int m = 0; m < 4; ++m)
#pragma unroll
                    for (int n = 0; n < 2; ++n) acc[a][b][m][n] = (f32x4){0.f, 0.f, 0.f, 0.f};
        cur = nxt; cA = nA; cB = nB; ++ui;
        if constexpr (ALIGN_EPI) { if (wr == 1) PG8_BAR; }
    }
    PG8_WAIT_V(0);
    if constexpr (!ALIGN_EPI) { if (wr == 0) PG8_BAR; }
    PG8_BAR;
    if constexpr (Epi::AFTER_DRAIN) { E.fused(acc, cur, wr, wc, fr, fq, lds, wid, lane); S.done(cur); }
#undef PG8_SA
#undef PG8_SB
#undef PG8_STAGE
#undef PG8_LDA
#undef PG8_LDB
#undef PG8_MMA
#undef PG8_WAIT_V
#undef PG8_WAIT_L
#undef PG8_BAR
#undef PG8_SCHED
}
}
#ifndef PG8_SP2
#define PG8_SP2 true
#endif
#ifndef PG8_ALIGN
#define PG8_ALIGN true
#endif
constexpr int NWAVES = 8;
#ifndef MK_N_LAUNCHES
#define MK_N_LAUNCHES 1
#endif
#define UKV_MAP 1
constexpr int BATCH = 4, SEQ = 4096, D = 1024, M = BATCH * SEQ, FF = 4096;
constexpr int HA = 8, DA = 64, WA = 512;
constexpr int HB = 8, DN = 64, DR = 32, DQK = 96, DV = 64;
constexpr int QLR = 768, KVLR = 256;
constexpr int NIN = 2592, NIN_PAD = 2816;
constexpr float EPS = 1e-6f;
constexpr float LOG2E = 1.4426950408889634f;
constexpr float QSCALE_A = 0.125f * LOG2E;
constexpr float QSCALE_B = 0.10206207261596575f * LOG2E;

constexpr size_t MiB = 1u << 20;
constexpr size_t WS_CTL = 0, CTL_ZERO_BYTES = 32 * 1024;
constexpr size_t WS_WIN = 1 * MiB;
constexpr size_t WS_WUQ = 7 * MiB;
constexpr size_t WS_WUKV = 8 * MiB + 512 * 1024;
constexpr size_t WS_WO = 9 * MiB;
constexpr size_t WS_W1 = 11 * MiB;
constexpr size_t WS_W2 = 19 * MiB;
constexpr size_t WS_CS = 27 * MiB;
constexpr size_t WS_KR = 29 * MiB;
constexpr size_t WS_SSQCQ = 31 * MiB;
constexpr size_t WS_SKR = 31 * MiB + 768 * 1024;
constexpr size_t WS_BIAS = 31 * MiB + 832 * 1024;
constexpr size_t WS_SSQCKV = 32 * MiB;
constexpr size_t WS_IRX = 32 * MiB + 512 * 1024;
constexpr size_t WS_SSQH = 27 * MiB;
constexpr size_t WS_ML = 33 * MiB;
constexpr size_t WS_XN = 36 * MiB;
constexpr size_t WS_H1B = 36 * MiB;
constexpr size_t WS_QA = 68 * MiB, WS_KA = 84 * MiB, WS_VA = 100 * MiB;
constexpr size_t WS_CQ = 116 * MiB;
constexpr size_t WS_CKV = 140 * MiB;
constexpr size_t WS_MIX = 116 * MiB;
constexpr size_t WS_QB = 148 * MiB;
constexpr size_t WS_KBN = 172 * MiB;
constexpr size_t WS_KBR = 188 * MiB;
constexpr size_t WS_VB = 196 * MiB;
constexpr size_t WS_HID = 128 * MiB;
constexpr size_t WS_END = 256 * MiB;

constexpr int CW_TMO = 0, CW_CODE = 1;
constexpr int CW_BAR = 4096;
constexpr int CW_AQ = 2048;
constexpr int RING_OFF = 0, RING_BYTES = 131072;
constexpr int LDSCTL_OFF = 139264, MISC_OFF = LDSCTL_OFF + 320;
constexpr int LDS_BYTES = 147456;
#define GAS __attribute__((address_space(1)))
#define LAS __attribute__((address_space(3)))
typedef unsigned short bf16;
typedef unsigned v4u __attribute__((ext_vector_type(4)));
typedef float f32x4 __attribute__((ext_vector_type(4)));
typedef short bf16x8 __attribute__((ext_vector_type(8)));
typedef GAS unsigned gu32;
typedef GAS unsigned long long gu64;
#define RLX_AGENT __ATOMIC_RELAXED, __HIP_MEMORY_SCOPE_AGENT
#define LDS_WAIT() asm volatile("s_waitcnt lgkmcnt(0)" ::: "memory")
#define VM_WAIT() asm volatile("s_waitcnt vmcnt(0)" ::: "memory")
__device__ __forceinline__ unsigned long long rt() { return __builtin_amdgcn_s_memrealtime(); }
__device__ __forceinline__ unsigned f2bf(float f) { unsigned u = __builtin_bit_cast(unsigned, f); return (u + 0x7fffu + ((u >> 16) & 1u)) >> 16; }
__device__ __forceinline__ unsigned pk2(float lo, float hi) { return f2bf(lo) | (f2bf(hi) << 16); }

#define XB_TMO      128
#define XB_XCNT(j)  (256  + 64 * (j))
#define XB_XSUB(j)  (1280 + 64 * (j))
#define XB_XGEN(j)  (2304 + 64 * (j))
#define XB_TOP      3328
#define XB_TOPGEN   3392
#define XCD_BAR_WORDS 3456
#define XB_SPIN_CAP (1u << 18)

__device__ __forceinline__ unsigned xb_ld(unsigned* p)              { return __hip_atomic_load(p, __ATOMIC_RELAXED, __HIP_MEMORY_SCOPE_AGENT); }
__device__ __forceinline__ unsigned xb_add(unsigned* p, unsigned v) { return __hip_atomic_fetch_add(p, v, __ATOMIC_RELAXED, __HIP_MEMORY_SCOPE_AGENT); }
__device__ __forceinline__ unsigned xb_xcc_id() { return (unsigned)__builtin_amdgcn_s_getreg((3 << 11) | 20) & 0xFu; }
#define XB_SPIN(cond, bar) do { unsigned _sp = 0; while (cond) { __builtin_amdgcn_s_sleep(1); \
    if ((++_sp & 255u) == 0u) { if (xb_ld(&(bar)[XB_TMO])) break; if (_sp > XB_SPIN_CAP) { atomicAdd(&(bar)[XB_TMO], 1u); break; } } } } while (0)

struct XcdBarrier {
    unsigned* bar; unsigned x;
    volatile LAS unsigned* st;
};

__device__ __forceinline__ XcdBarrier xcd_barrier_post(unsigned* bar, volatile LAS unsigned* st) {
    XcdBarrier b; b.bar = bar; b.x = xb_xcc_id(); b.st = st;
    if (threadIdx.x == 0) (void)xb_add(&bar[XB_XCNT(b.x)], 1u);
    return b;
}
__device__ __forceinline__ void xcd_barrier_complete(unsigned* bar, unsigned x, unsigned& nloc, unsigned& nx) {
    const unsigned G = gridDim.x * gridDim.y * gridDim.z;
    unsigned sum, cnt, mine, sp = 0u;
    for (;;) {
        sum = 0u; cnt = 0u; mine = 0u;
#pragma unroll
        for (unsigned j = 0; j < 16; ++j) { const unsigned c = xb_ld(&bar[XB_XCNT(j)]); sum += c; cnt += (c > 0u) ? 1u : 0u; mine = (j == x) ? c : mine; }
        if (sum == G) break;
        __builtin_amdgcn_s_sleep(1);
        if ((++sp & 255u) == 0u) { if (xb_ld(&bar[XB_TMO])) break; if (sp > XB_SPIN_CAP) { atomicAdd(&bar[XB_TMO], 1u); break; } }
    }
    nloc = mine > 0u ? mine : 1u; nx = cnt > 0u ? cnt : 1u;
}

__device__ __forceinline__ void xcd_barrier(const XcdBarrier& b) {
    asm volatile("s_waitcnt vmcnt(0)" ::: "memory");
    __syncthreads();
    if (threadIdx.x == 0) {
        unsigned* bar = b.bar;
        __builtin_amdgcn_s_waitcnt(0);
        unsigned nloc = b.st[0], nx = b.st[1];
        if (nloc == 0u) { xcd_barrier_complete(bar, b.x, nloc, nx); b.st[0] = nloc; b.st[1] = nx; }
        const unsigned old = xb_add(&bar[XB_XSUB(b.x)], 1u);
        const unsigned gen = old / nloc;
        if (old + 1u == (gen + 1u) * nloc) {
            __builtin_amdgcn_fence(__ATOMIC_RELEASE, "agent");
            asm volatile("s_waitcnt vmcnt(0)" ::: "memory");
            const unsigned og = xb_add(&bar[XB_TOP], 1u);
            const unsigned tg = og / nx;
            if (og + 1u == (tg + 1u) * nx) xb_add(&bar[XB_TOPGEN], 1u);
            else XB_SPIN(xb_ld(&bar[XB_TOPGEN]) == tg, bar);
            __builtin_amdgcn_fence(__ATOMIC_ACQUIRE, "agent");
            xb_add(&bar[XB_XGEN(b.x)], 1u);
            asm volatile("s_waitcnt vmcnt(0)" ::: "memory");
        } else {
            XB_SPIN(xb_ld(&bar[XB_XGEN(b.x)]) == gen, bar);
            __builtin_amdgcn_fence(__ATOMIC_ACQUIRE, "agent");
            asm volatile("s_waitcnt vmcnt(0)" ::: "memory");
        }
    }
    __syncthreads();
}
struct Frame {
    LAS unsigned char* lds;
    volatile LAS unsigned* MISC;
    gu32* ctl;
    int tid, lane, wave;
    int vcu, G;
};
__device__ __forceinline__ float wave_sum(float v) {
#pragma unroll
    for (int o = 1; o < 64; o <<= 1) v += __shfl_xor(v, o);
    return v;
}
__device__ __forceinline__ float bf2f(unsigned short u) { return __uint_as_float((unsigned)u << 16); }
__device__ __forceinline__ float bflo(unsigned w) { return __uint_as_float(w << 16); }
__device__ __forceinline__ float bfhi(unsigned w) { return __uint_as_float(w & 0xffff0000u); }

__device__ __forceinline__ int rowmap_sigma(int n) { if (n >= 2560) { const int d = n - 2560; return 2560 + (d < 16 ? d : 112 + d); } const int c = n & 255; return (n & ~255) + 128 * ((c >> 5) & 1) + 32 * (c >> 6) + (c & 31); }
template <int MAP> __device__ __forceinline__ void p0_transpose_item(const float* W, int K, int N, bf16* WT, const float* kscale, LAS float* scr, int item, int lane) {
    const int nblk = N / 32, kb = item / nblk, nb = item % nblk, k0 = 64 * kb, n0 = 32 * nb;
    f32x4 w[8]; const int rr = lane >> 3, c4 = (lane & 7) * 4;
#pragma unroll
    for (int i = 0; i < 8; ++i) w[i] = *(const GAS f32x4*)(W + (size_t)(k0 + 8 * i + rr) * N + n0 + c4);
#pragma unroll
    for (int i = 0; i < 8; ++i) { const int kk = 8 * i + rr; f32x4 v = w[i]; if (kscale) v = v * kscale[k0 + kk];
        scr[kk * 33 + c4] = v.x; scr[kk * 33 + c4 + 1] = v.y; scr[kk * 33 + c4 + 2] = v.z; scr[kk * 33 + c4 + 3] = v.w; }
    LDS_WAIT(); asm volatile("" ::: "memory");
    const int c = lane & 7;
#pragma unroll
    for (int j = 0; j < 4; ++j) { const int n = (lane >> 3) + 8 * j; const LAS float* s = scr + (8 * c) * 33 + n;
        v4u o; o.x = pk2(s[0 * 33], s[1 * 33]); o.y = pk2(s[2 * 33], s[3 * 33]); o.z = pk2(s[4 * 33], s[5 * 33]); o.w = pk2(s[6 * 33], s[7 * 33]);
        const int drow = MAP == 2 ? ((((n0 + n) & ~255) + 128 * (((n0 + n) >> 5) & 1) + 32 * (((n0 + n) & 255) >> 6) + ((n0 + n) & 31))) : (MAP ? rowmap_sigma(n0 + n) : (n0 + n)); *(GAS v4u*)(WT + (size_t)drow * K + k0 + 8 * c) = o; }
    LDS_WAIT(); asm volatile("" ::: "memory");
}
struct In { const float* x; const int* pos; const float *g_mix, *w_in, *g_qa, *g_ka, *rel_bias, *g_cq, *g_ckv, *w_uq, *w_ukv, *g_qb, *g_kb, *w_o, *g_ffn, *w1, *w2; };

__device__ __forceinline__ float inv_freq(int k) {
    const float t[16] = {1.000000000e+00f, 5.623413324e-01f, 3.162277639e-01f, 1.778279394e-01f, 1.000000015e-01f, 5.623413250e-02f, 3.162277490e-02f, 1.778279431e-02f,
                         9.999999776e-03f, 5.623413250e-03f, 3.162277630e-03f, 1.778279431e-03f, 1.000000047e-03f, 5.623413017e-04f, 3.162277571e-04f, 1.778279402e-04f};
    float r = t[0];
#pragma unroll
    for (int i = 1; i < 16; ++i) r = (k == i) ? t[i] : r;
    return r;
}
__device__ __forceinline__ int t5_bucket(int dist) {
    if (dist < 16) return dist;
    int l = 16 + (int)(logf((float)dist * (1.0f / 16.0f)) / 4.852030263919617f * 16.0f);
    return l < 31 ? l : 31;
}
constexpr int I_IN = (D / 64) * (NIN / 32), I_UQ = (QLR / 64) * (768 / 32), I_UKV = (KVLR / 64) * (1024 / 32), I_O = (D / 64) * (D / 32), I_1 = (D / 64) * (FF / 32), I_2 = (FF / 64) * (D / 32);
__device__ __forceinline__ void p0b_items(Frame& F, const In& I, unsigned char* ws, int gw, int NGW, int part) {
    LAS float* scr = (LAS float*)(F.lds + RING_OFF + F.wave * 16384);
    bf16* Wuq = (bf16*)(ws + WS_WUQ); bf16* Wukv = (bf16*)(ws + WS_WUKV); bf16* Wo = (bf16*)(ws + WS_WO); bf16* W1 = (bf16*)(ws + WS_W1); bf16* W2 = (bf16*)(ws + WS_W2);
    if (part == 1) { for (int it = gw; it < I_2; it += NGW) p0_transpose_item<0>(I.w2, FF, D, W2, nullptr, scr, it, F.lane); return; }
    constexpr int NITEMS = I_UQ + I_UKV + I_O + I_1;
    const int it_lo = (part == 4) ? NITEMS / 2 : 0, it_hi = (part == 3) ? NITEMS / 2 : NITEMS;
    for (int it = it_lo + gw; it < it_hi; it += NGW) {
        int r = it;
        if (r < I_UQ) { p0_transpose_item<0>(I.w_uq, QLR, 768, Wuq, I.g_cq, scr, r, F.lane); continue; } r -= I_UQ;
        if (r < I_UKV) { p0_transpose_item<UKV_MAP>(I.w_ukv, KVLR, 1024, Wukv, I.g_ckv, scr, r, F.lane); continue; } r -= I_UKV;
        if (r < I_O) { p0_transpose_item<0>(I.w_o, D, D, Wo, nullptr, scr, r, F.lane); continue; } r -= I_O;
        p0_transpose_item<2>(I.w1, D, FF, W1, I.g_ffn, scr, r, F.lane);
    }
}
__device__ __forceinline__ void p0_prologue(Frame& F, const In& I, unsigned char* ws) {
    LAS float* scr = (LAS float*)(F.lds + RING_OFF + F.wave * 16384);
    const int gw = F.vcu * NWAVES + F.wave, NGW = F.G * NWAVES;
    const int gt = gw * 64 + F.lane, NGT = NGW * 64;
    bf16* Win = (bf16*)(ws + WS_WIN);
    for (int it = gw; it < I_IN; it += NGW) p0_transpose_item<1>(I.w_in, D, NIN, Win, nullptr, scr, it, F.lane);
    { const int n16 = 112 * D * 2 / 16; GAS v4u* z0 = (GAS v4u*)(Win + (size_t)(2560 + 16) * D); GAS v4u* z1 = (GAS v4u*)(Win + (size_t)(2560 + 144) * D);
      for (int i = gt; i < n16; i += NGT) { z0[i] = (v4u){0u, 0u, 0u, 0u}; z1[i] = (v4u){0u, 0u, 0u, 0u}; } }
    bf16* XN = (bf16*)(ws + WS_XN);
    f32x4 g[4];
#pragma unroll
    for (int j = 0; j < 4; ++j) g[j] = *((const GAS f32x4*)I.g_mix + F.lane + 64 * j);
    for (int m0 = gw * 4; m0 < M; m0 += NGW * 4) {
        f32x4 v[4][4];
#pragma unroll
        for (int r = 0; r < 4; ++r)
#pragma unroll
            for (int j = 0; j < 4; ++j) v[r][j] = *((const GAS f32x4*)(I.x + (size_t)(m0 + r) * D) + F.lane + 64 * j);
#pragma unroll
        for (int r = 0; r < 4; ++r) { float s2 = 0.f;
#pragma unroll
            for (int j = 0; j < 4; ++j) s2 += (v[r][j].x * v[r][j].x + v[r][j].y * v[r][j].y) + (v[r][j].z * v[r][j].z + v[r][j].w * v[r][j].w);
            const float rstd = 1.f / sqrtf(wave_sum(s2) * (1.f / D) + EPS);
            GAS unsigned long long* o8 = (GAS unsigned long long*)(XN + (size_t)(m0 + r) * D) + F.lane;
#pragma unroll
            for (int j = 0; j < 4; ++j) o8[64 * j] = (unsigned long long)pk2(v[r][j].x * rstd * g[j].x, v[r][j].y * rstd * g[j].y) | ((unsigned long long)pk2(v[r][j].z * rstd * g[j].z, v[r][j].w * rstd * g[j].w) << 32); }
    }
    { float2* CS = (float2*)(ws + WS_CS);
      for (int i = gt; i < M * 16; i += NGT) { const int m = i >> 4, k = i & 15; const float ang = (float)I.pos[m] * inv_freq(k);
          const double a = (double)ang; const double n = __builtin_rint(a * 0.15915494309189535); const float r = (float)(a - n * 6.283185307179586);
          CS[i] = make_float2(__cosf(r), __sinf(r)); } }
    { float* BT = (float*)(ws + WS_BIAS);
      for (int i = gt; i < 3 * 8 * 132; i += NGT) { const int br = i / (8 * 132), h = (i / 132) % 8, j = i % 132; const int dil = br == 0 ? 1 : (br == 1 ? 4 : 16);
          BT[i] = j <= 128 ? I.rel_bias[t5_bucket(dil * j) * 8 + h] * LOG2E : 0.f; } }
}
namespace attb {
using bf16x8 = __attribute__((ext_vector_type(8))) short;
using s16x4 = __attribute__((ext_vector_type(4))) short;
using f32x16 = __attribute__((ext_vector_type(16))) float;
using u32x4 = __attribute__((ext_vector_type(4))) unsigned;
typedef short v4i16_t __attribute__((ext_vector_type(4)));
typedef __attribute__((address_space(3))) const char* lds_cptr;
typedef __attribute__((address_space(3))) char* lds_ptr;
constexpr int QB_ROWS = 256, KVBLK = 64, NQB = SEQ / QB_ROWS;
constexpr int KSLOT = 12288, VSLOT = 8192, NSLOT = 3;
constexpr int NVSLOT = 3, NKSLOT = 4;
constexpr int L_K = 0, L_V = NKSLOT * KSLOT, L_WS = L_V + NVSLOT * VSLOT, L_OST = L_WS + NWAVES * 256, L_BYTES = L_OST + NWAVES * 4096;
constexpr float THR = 6.0f;
constexpr float THR_B = 24.0f;
__device__ __forceinline__ int crow(int r, int hi) { return (r & 3) + 8 * (r >> 2) + 4 * hi; }
__device__ __forceinline__ void glds16(const void* gsrc, unsigned lds_dst) { unsigned keep;
    asm volatile("s_mov_b32 %0, m0\n\ts_mov_b32 m0, %2\n\ts_nop 0\n\tglobal_load_lds_dwordx4 %1, off\n\ts_mov_b32 m0, %0" : "=&s"(keep) : "v"(gsrc), "s"(lds_dst) : "memory"); }
typedef float f32x2_t __attribute__((ext_vector_type(2))); typedef __bf16 bf16x2_t __attribute__((ext_vector_type(2)));
__device__ __forceinline__ unsigned cvtpk(float lo, float hi) { f32x2_t v = {lo, hi}; bf16x2_t b = __builtin_convertvector(v, bf16x2_t); return __builtin_bit_cast(unsigned, b); }
__device__ __forceinline__ s16x4 vtr(lds_cptr p) { return __builtin_bit_cast(s16x4, __builtin_amdgcn_ds_read_tr16_b64_v4i16((__attribute__((address_space(3))) v4i16_t*)p)); }
__device__ __forceinline__ float max3f(float a, float b, float c) { float r; asm("v_max3_f32 %0, %1, %2, %3" : "=v"(r) : "v"(a), "v"(b), "v"(c)); return r; }
__device__ __forceinline__ float max2f(float a, float b) { float r; asm("v_max_f32_e32 %0, %1, %2" : "=v"(r) : "v"(a), "v"(b)); return r; }
__device__ __forceinline__ float fadd_s(float a, float b) { float r; asm("v_add_f32_e32 %0, %1, %2" : "=v"(r) : "v"(a), "v"(b)); return r; }
#define MX3(a, b, c) max3f((a), (b), (c))
__device__ __forceinline__ float rowmax32(const f32x16& p0, const f32x16& p1) {
    const float a0 = MX3(p0[0], p0[1], p0[2]), a1 = MX3(p0[3], p0[4], p0[5]), a2 = MX3(p0[6], p0[7], p0[8]), a3 = MX3(p0[9], p0[10], p0[11]), a4 = MX3(p0[12], p0[13], p0[14]);
    const float a5 = MX3(p1[0], p1[1], p1[2]), a6 = MX3(p1[3], p1[4], p1[5]), a7 = MX3(p1[6], p1[7], p1[8]), a8 = MX3(p1[9], p1[10], p1[11]), a9 = MX3(p1[12], p1[13], p1[14]);
    const float a10 = max2f(p0[15], p1[15]);
    const float b0 = MX3(a0, a1, a2), b1 = MX3(a3, a4, a5), b2 = MX3(a6, a7, a8), b3 = MX3(a9, a10, a10);
    const float m = max2f(MX3(b0, b1, b2), b3);
    auto rr = __builtin_amdgcn_permlane32_swap(__float_as_uint(m), __float_as_uint(m), false, false);
    return max2f(__uint_as_float(rr[0]), __uint_as_float(rr[1]));
}
__device__ __forceinline__ float rowsum32(const f32x16& p0, const f32x16& p1) {
    float t[16];
#pragma unroll
    for (int r = 0; r < 16; ++r) t[r] = fadd_s(p0[r], p1[r]);
#pragma unroll
    for (int r = 0; r < 8; ++r) t[r] = fadd_s(t[r], t[r + 8]);
#pragma unroll
    for (int r = 0; r < 4; ++r) t[r] = fadd_s(t[r], t[r + 4]);
    return fadd_s(fadd_s(t[0], t[2]), fadd_s(t[1], t[3]));
}
#define ATTB_WAIT_BAR(N) asm volatile("s_waitcnt vmcnt(" #N ") lgkmcnt(0)\n\ts_barrier" ::: "memory")
template <int VAR> __device__ __forceinline__ void unit(int b, int h, int qb, const bf16* Q, const bf16* KN, const bf16* KR, const bf16* V, bf16* O, lds_ptr shm, const float* g_qb, const float2* CS, const bf16* PO, const float2* ML, const bool fast) {
    int tid_ = threadIdx.x; asm volatile("" : "+v"(tid_));
    const int tid = tid_, lane = tid & 63, r32 = lane & 31, hi = lane >> 5; const int wid = __builtin_amdgcn_readfirstlane(tid >> 6);
    const long rowbase = (long)b * SEQ; const int q0 = qb * QB_ROWS;
    const unsigned lds0 = (unsigned)(uintptr_t)shm;
    __attribute__((address_space(3))) float* wsf = (__attribute__((address_space(3))) float*)(shm + L_WS) + wid * 64;
    const int krow = wid * 8 + (lane >> 3), rrow = (wid & 3) * 16 + (lane >> 2);
    const bf16* ksrc0 = KN + (rowbase + krow) * 512 + 64 * h + (((lane & 7) ^ ((krow >> 1) & 7)) * 8);
    const bf16* ksrc1 = KR + (rowbase + rrow) * 256 + 32 * h + (((lane & 3) ^ ((rrow >> 2) & 3)) * 8);
    const bf16* vsrc = V + (rowbase + 16 * (wid & 3) + (lane >> 2)) * 512 + 64 * h + (wid >> 2) * 32 + (lane & 3) * 8;
    const unsigned kdst0 = lds0 + L_K + wid * 1024, kdst1 = lds0 + L_K + 8192 + (wid & 3) * 1024, vdst = lds0 + L_V + wid * 1024;
#define ATTB_DMA_K(t, ks_) do { glds16(ksrc0 + (long)(t) * KVBLK * 512, (unsigned)__builtin_amdgcn_readfirstlane(kdst0 + (ks_) * KSLOT)); \
        if (wid < 4) glds16(ksrc1 + (long)(t) * KVBLK * 256, (unsigned)__builtin_amdgcn_readfirstlane(kdst1 + (ks_) * KSLOT)); } while (0)
#define ATTB_DMA_V(t, vs_) glds16(vsrc + (long)(t) * KVBLK * 512, (unsigned)__builtin_amdgcn_readfirstlane(vdst + (vs_) * VSLOT))
#define ATTB_DMA(t, ks_, vs_) do { ATTB_DMA_K(t, ks_); ATTB_DMA_V(t, vs_); } while (0)
    const int NT = (q0 + QB_ROWS) / KVBLK;
    ATTB_DMA(0, 0, 0); ATTB_DMA(1, 1, 1); if (fast) ATTB_DMA_K(2, 2);
    bf16x8 qr[6];
    { const long tok = rowbase + q0 + wid * 32 + r32; const bf16* Qw = Q + tok * 768 + 96 * h + hi * 8;
      float qv[6][8]; float ss = 0.f;
#pragma unroll
      for (int d0 = 0; d0 < 6; ++d0) { const u32x4 raw = *reinterpret_cast<const u32x4*>(Qw + d0 * 16);
          qv[d0][0] = bflo(raw.x); qv[d0][1] = bfhi(raw.x); qv[d0][2] = bflo(raw.y); qv[d0][3] = bfhi(raw.y); qv[d0][4] = bflo(raw.z); qv[d0][5] = bfhi(raw.z); qv[d0][6] = bflo(raw.w); qv[d0][7] = bfhi(raw.w);
#pragma unroll
          for (int j = 0; j < 8; ++j) ss += qv[d0][j] * qv[d0][j]; }
      ss += __shfl_xor(ss, 32);
      const float rstd = 1.0f / sqrtf(ss * (1.0f / 96.0f) + EPS);
#pragma unroll
      for (int d0 = 0; d0 < 6; ++d0) { const f32x4 g0 = *(const f32x4*)(g_qb + 16 * d0 + 8 * hi), g1 = *(const f32x4*)(g_qb + 16 * d0 + 8 * hi + 4);
#pragma unroll
          for (int j = 0; j < 4; ++j) { qv[d0][j] *= rstd * g0[j]; qv[d0][4 + j] *= rstd * g1[j]; } }
#pragma unroll
      for (int j = 0; j < 8; ++j) { const float2 cs = CS[tok * 16 + 8 * hi + j]; const float x1 = qv[4][j], x2 = qv[5][j]; qv[4][j] = x1 * cs.x - x2 * cs.y; qv[5][j] = x2 * cs.x + x1 * cs.y; }
#pragma unroll
      for (int d0 = 0; d0 < 6; ++d0) { const u32x4 w = (u32x4){cvtpk(qv[d0][0] * QSCALE_B, qv[d0][1] * QSCALE_B), cvtpk(qv[d0][2] * QSCALE_B, qv[d0][3] * QSCALE_B), cvtpk(qv[d0][4] * QSCALE_B, qv[d0][5] * QSCALE_B), cvtpk(qv[d0][6] * QSCALE_B, qv[d0][7] * QSCALE_B)};
          qr[d0] = __builtin_bit_cast(bf16x8, w); } }
    float mhat = 0.f, l_run = 0.f; f32x16 o[2]; o[0] = f32x16{}; o[1] = f32x16{};
    const int qrel = wid * 32 + r32;
    const lds_cptr kp0 = (lds_cptr)shm + L_K + r32 * 128, kr0 = (lds_cptr)shm + L_K + 8192 + r32 * 64;
    int koff[6];
#pragma unroll
    for (int d0 = 0; d0 < 4; ++d0) koff[d0] = ((2 * d0 + hi) ^ ((r32 >> 1) & 7)) * 16;
#pragma unroll
    for (int d0 = 4; d0 < 6; ++d0) koff[d0] = ((2 * (d0 - 4) + hi) ^ ((r32 >> 2) & 3)) * 16;
    const lds_cptr vp0 = (lds_cptr)shm + L_V + ((lane >> 4) & 1) * 32 + (lane & 3) * 8 + (4 * hi + ((lane & 15) >> 2)) * 64;
    f32x16 p0, p1; const f32x16 zero16 = f32x16{};
#define ATTB_SKIP(tt) (((tt) - (NT - 4)) >= 1 && wid < 2 * ((tt) - (NT - 4)))
#define ATTB_QK(tt, sl) do { if (!ATTB_SKIP(tt)) { const lds_cptr kp = kp0 + (sl) * KSLOT, kr = kr0 + (sl) * KSLOT; \
        bf16x8 kf[12];     \
        _Pragma("unroll") for (int d0 = 0; d0 < 6; ++d0) { const lds_cptr ka = (d0 < 4 ? kp : kr) + koff[d0]; \
            kf[2 * d0] = *(const __attribute__((address_space(3))) bf16x8*)(ka); kf[2 * d0 + 1] = *(const __attribute__((address_space(3))) bf16x8*)(ka + (d0 < 4 ? 4096 : 2048)); } \
        __builtin_amdgcn_sched_barrier(0); \
        p0 = __builtin_amdgcn_mfma_f32_32x32x16_bf16(kf[0], qr[0], zero16, 0, 0, 0); p1 = __builtin_amdgcn_mfma_f32_32x32x16_bf16(kf[1], qr[0], zero16, 0, 0, 0); \
        _Pragma("unroll") for (int d0 = 1; d0 < 6; ++d0) { p0 = __builtin_amdgcn_mfma_f32_32x32x16_bf16(kf[2 * d0], qr[d0], p0, 0, 0, 0); p1 = __builtin_amdgcn_mfma_f32_32x32x16_bf16(kf[2 * d0 + 1], qr[d0], p1, 0, 0, 0); } \
        __builtin_amdgcn_sched_barrier(0); \
        const int jb_ = (tt) - (NT - 4); \
        if (jb_ >= 0) { const int kb = 64 * jb_ + 4 * hi; \
            _Pragma("unroll") for (int r = 0; r < 16; ++r) { const int kv = kb + (r & 3) + 8 * (r >> 2); if (kv > qrel) p0[r] = -INFINITY; if (kv + 32 > qrel) p1[r] = -INFINITY; } } } } while (0)
#define ATTB_SMPV(tt, sl) do { if (!ATTB_SKIP(tt)) { const lds_cptr vp = vp0 + (sl) * VSLOT; \
        float rm = rowmax32(p0, p1);        \
        if (__any(rm - mhat > THR_B)) { \
            const float dl = fmaxf(rm - mhat, 0.f), f = __builtin_amdgcn_exp2f(-dl); \
            mhat += dl; l_run *= f; \
            if (hi == 0) wsf[r32] = f; \
            asm volatile("s_waitcnt lgkmcnt(0)" ::: "memory"); \
            _Pragma("unroll") for (int r = 0; r < 16; ++r) { const float fr = wsf[crow(r, hi)]; o[0][r] *= fr; o[1][r] *= fr; } \
        } \
        if (__any(mhat != 0.f)) { _Pragma("unroll") for (int r = 0; r < 16; ++r) { p0[r] -= mhat; p1[r] -= mhat; } } \
        _Pragma("unroll") for (int r = 0; r < 16; ++r) { p0[r] = __builtin_amdgcn_exp2f(p0[r]); p1[r] = __builtin_amdgcn_exp2f(p1[r]); } \
        l_run += rowsum32(p0, p1); \
        u32x4 pw[4]; \
        _Pragma("unroll") for (int k = 0; k < 2; ++k) { pw[k] = (u32x4){cvtpk(p0[8 * k], p0[8 * k + 1]), cvtpk(p0[8 * k + 2], p0[8 * k + 3]), cvtpk(p0[8 * k + 4], p0[8 * k + 5]), cvtpk(p0[8 * k + 6], p0[8 * k + 7])}; \
            pw[2 + k] = (u32x4){cvtpk(p1[8 * k], p1[8 * k + 1]), cvtpk(p1[8 * k + 2], p1[8 * k + 3]), cvtpk(p1[8 * k + 4], p1[8 * k + 5]), cvtpk(p1[8 * k + 6], p1[8 * k + 7])}; } \
        s16x4 vl[8], vh[8];     \
        _Pragma("unroll") for (int i = 0; i < 8; ++i) { vl[i] = vtr(vp + (i >> 2) * 4096 + (i & 3) * 1024); vh[i] = vtr(vp + (i >> 2) * 4096 + (i & 3) * 1024 + 512); } \
        __builtin_amdgcn_sched_barrier(0); \
        _Pragma("unroll") for (int ks = 0; ks < 4; ++ks) \
            _Pragma("unroll") for (int d0 = 0; d0 < 2; ++d0) { const int i = 4 * d0 + ks; \
                const bf16x8 vf = (bf16x8){vl[i][0], vl[i][1], vl[i][2], vl[i][3], vh[i][0], vh[i][1], vh[i][2], vh[i][3]}; \
                o[d0] = __builtin_amdgcn_mfma_f32_32x32x16_bf16(__builtin_bit_cast(bf16x8, pw[ks]), vf, o[d0], 0, 0, 0); } \
        __builtin_amdgcn_sched_barrier(0); } } while (0)
    if (!fast) {
    for (int i = 0; i < NT; ++i) {
        if (i + 1 < NT) { if (wid < 4) ATTB_WAIT_BAR(3); else ATTB_WAIT_BAR(2); } else ATTB_WAIT_BAR(0);
        if (i + 2 < NT) ATTB_DMA(i + 2, (i + 2) % 3, (i + 2) % 3);
        ATTB_QK(i, i % 3);
        ATTB_SMPV(i, i % 3);
    }
    } else {
#define ATTB_FQK(PN0, PN1, tt) do { const lds_cptr kp = kp0 + ((tt) & 3) * KSLOT, kr = kr0 + ((tt) & 3) * KSLOT; \
        bf16x8 ka_[6], kb_[6]; \
        _Pragma("unroll") for (int d0 = 0; d0 < 3; ++d0) { ka_[2 * d0] = *(const __attribute__((address_space(3))) bf16x8*)(kp + koff[d0]); ka_[2 * d0 + 1] = *(const __attribute__((address_space(3))) bf16x8*)(kp + koff[d0] + 4096); } \
        kb_[0] = *(const __attribute__((address_space(3))) bf16x8*)(kp + koff[3]); kb_[1] = *(const __attribute__((address_space(3))) bf16x8*)(kp + koff[3] + 4096); \
        _Pragma("unroll") for (int d0 = 4; d0 < 6; ++d0) { kb_[2 * (d0 - 3)] = *(const __attribute__((address_space(3))) bf16x8*)(kr + koff[d0]); kb_[2 * (d0 - 3) + 1] = *(const __attribute__((address_space(3))) bf16x8*)(kr + koff[d0] + 2048); } \
        PN0 = __builtin_amdgcn_mfma_f32_32x32x16_bf16(ka_[0], qr[0], zero16, 0, 0, 0); PN1 = __builtin_amdgcn_mfma_f32_32x32x16_bf16(ka_[1], qr[0], zero16, 0, 0, 0); \
        _Pragma("unroll") for (int d0 = 1; d0 < 3; ++d0) { PN0 = __builtin_amdgcn_mfma_f32_32x32x16_bf16(ka_[2 * d0], qr[d0], PN0, 0, 0, 0); PN1 = __builtin_amdgcn_mfma_f32_32x32x16_bf16(ka_[2 * d0 + 1], qr[d0], PN1, 0, 0, 0); } \
        _Pragma("unroll") for (int d0 = 3; d0 < 6; ++d0) { PN0 = __builtin_amdgcn_mfma_f32_32x32x16_bf16(kb_[2 * (d0 - 3)], qr[d0], PN0, 0, 0, 0); PN1 = __builtin_amdgcn_mfma_f32_32x32x16_bf16(kb_[2 * (d0 - 3) + 1], qr[d0], PN1, 0, 0, 0); } } while (0)
#define ATTB_FMASK(PN0, PN1, tt) do { const int jb_ = (tt) - (NT - 4); \
        if (jb_ >= 0) { const int kb = 64 * jb_ + 4 * hi; \
            _Pragma("unroll") for (int r = 0; r < 16; ++r) { const int kv = kb + (r & 3) + 8 * (r >> 2); if (kv > qrel) PN0[r] = -INFINITY; if (kv + 32 > qrel) PN1[r] = -INFINITY; } } } while (0)
#define ATTB_FEXP(P0_, P1_) do { _Pragma("unroll") for (int r = 0; r < 16; ++r) { P0_[r] = __builtin_amdgcn_exp2f(P0_[r]); P1_[r] = __builtin_amdgcn_exp2f(P1_[r]); } } while (0)
#define ATTB_FSUMPACK(PC0, PC1) do { l_run += rowsum32(PC0, PC1); \
        _Pragma("unroll") for (int k = 0; k < 2; ++k) { pw[k] = (u32x4){cvtpk(PC0[8 * k], PC0[8 * k + 1]), cvtpk(PC0[8 * k + 2], PC0[8 * k + 3]), cvtpk(PC0[8 * k + 4], PC0[8 * k + 5]), cvtpk(PC0[8 * k + 6], PC0[8 * k + 7])}; \
            pw[2 + k] = (u32x4){cvtpk(PC1[8 * k], PC1[8 * k + 1]), cvtpk(PC1[8 * k + 2], PC1[8 * k + 3]), cvtpk(PC1[8 * k + 4], PC1[8 * k + 5]), cvtpk(PC1[8 * k + 6], PC1[8 * k + 7])}; } } while (0)
#define ATTB_FPV(tt) do { const lds_cptr vp = (lds_cptr)(uintptr_t)(((unsigned)(uintptr_t)(vp0 + ((tt) % 3) * VSLOT)) & 0x3ffffu);     \
        _Pragma("unroll") for (int ks = 0; ks < 4; ++ks) \
            _Pragma("unroll") for (int d0 = 0; d0 < 2; ++d0) { \
                const s16x4 lo = vtr(vp + d0 * 4096 + ks * 1024), hh = vtr(vp + d0 * 4096 + ks * 1024 + 512); \
                const bf16x8 vf = (bf16x8){lo[0], lo[1], lo[2], lo[3], hh[0], hh[1], hh[2], hh[3]}; \
                o[d0] = __builtin_amdgcn_mfma_f32_32x32x16_bf16(__builtin_bit_cast(bf16x8, pw[ks]), vf, o[d0], 0, 0, 0); } } while (0)
        f32x16 pn0, pn1, pc0, pc1; u32x4 pw[4];
        ATTB_WAIT_BAR(0);
        ATTB_FQK(pn0, pn1, 0); ATTB_FMASK(pn0, pn1, 0); ATTB_FEXP(pn0, pn1);
        int t = 0;
        for (; t + 6 <= NT; ++t) {
            if (t > 0) { if (wid < 4) ATTB_WAIT_BAR(3); else ATTB_WAIT_BAR(2); }
            ATTB_DMA_K(t + 3, (t + 3) & 3); ATTB_DMA_V(t + 2, (t + 2) % 3);
            pc0 = pn0; pc1 = pn1;
            ATTB_FQK(pn0, pn1, t + 1);
            ATTB_FSUMPACK(pc0, pc1);
            ATTB_FPV(t);
            ATTB_FEXP(pn0, pn1);
        }
        for (; t < NT; ++t) {
            if (t > 0) ATTB_WAIT_BAR(0);
            if (t + 3 < NT) ATTB_DMA_K(t + 3, (t + 3) & 3);
            if (t + 2 < NT) ATTB_DMA_V(t + 2, (t + 2) % 3);
            pc0 = pn0; pc1 = pn1;
            if (t + 1 < NT && !ATTB_SKIP(t + 1)) { ATTB_FQK(pn0, pn1, t + 1); ATTB_FMASK(pn0, pn1, t + 1); ATTB_FEXP(pn0, pn1); }
            if (!ATTB_SKIP(t)) { ATTB_FSUMPACK(pc0, pc1); ATTB_FPV(t); }
        }
#undef ATTB_FEXP
#undef ATTB_FSUMPACK
#undef ATTB_FPV
#undef ATTB_FQK
#undef ATTB_FMASK
    }
#undef ATTB_QK
#undef ATTB_SMPV
#undef ATTB_SKIP
    { auto rr = __builtin_amdgcn_permlane32_swap(__float_as_uint(l_run), __float_as_uint(l_run), false, false); l_run = __uint_as_float(rr[0]) + __uint_as_float(rr[1]); }
    if (hi == 0) wsf[32 + r32] = l_run;
    asm volatile("s_waitcnt lgkmcnt(0)" ::: "memory");
    float rli[16];
#pragma unroll
    for (int r = 0; r < 16; ++r) rli[r] = 1.0f / wsf[32 + crow(r, hi)];
    bf16* Ow = O + (rowbase + q0 + wid * 32) * 1024 + 512 + 64 * h;
    { __attribute__((address_space(3))) bf16* stg = (__attribute__((address_space(3))) bf16*)(shm + L_OST) + wid * 2048;
#pragma unroll
      for (int r = 0; r < 16; ++r) { const int orow = crow(r, hi);
#pragma unroll
          for (int d0 = 0; d0 < 2; ++d0) stg[orow * 64 + d0 * 32 + r32] = (bf16)f2bf(o[d0][r] * rli[r]); }
      asm volatile("s_waitcnt lgkmcnt(0)" ::: "memory");
#pragma unroll
      for (int i = 0; i < 4; ++i) { const int row = i * 8 + (lane >> 3), ch = lane & 7; const u32x4 v = *(const __attribute__((address_space(3))) u32x4*)(stg + row * 64 + ch * 8); *(u32x4*)(Ow + (long)row * 1024 + ch * 8) = v; } }
    { constexpr size_t PO_STRIDE = (size_t)M * 512;
      float2 mla[4][3]; u32x4 xs[4][3];
#pragma unroll
      for (int i = 0; i < 4; ++i) { const int row = i * 8 + (lane >> 3), ch = lane & 7; const size_t m = (size_t)(rowbase + q0 + wid * 32 + row);
#pragma unroll
          for (int br = 0; br < 3; ++br) { mla[i][br] = ML[((size_t)br * M + m) * 8 + h]; xs[i][br] = *(const u32x4*)(PO + br * PO_STRIDE + m * 512 + 64 * h + ch * 8); } }
      asm volatile("" ::: "memory");
#pragma unroll
      for (int i = 0; i < 4; ++i) { const int row = i * 8 + (lane >> 3), ch = lane & 7; const size_t m = (size_t)(rowbase + q0 + wid * 32 + row);
          const float2 a = mla[i][0], bq = mla[i][1], cq = mla[i][2];
          const float mx = fmaxf(fmaxf(a.x, bq.x), cq.x);
          float w0 = a.y * __builtin_amdgcn_exp2f(a.x - mx), w1 = bq.y * __builtin_amdgcn_exp2f(bq.x - mx), w2 = cq.y * __builtin_amdgcn_exp2f(cq.x - mx);
          const float inv = 1.0f / (w0 + w1 + w2); w0 *= inv; w1 *= inv; w2 *= inv;
          const u32x4 x0 = xs[i][0], x1 = xs[i][1], x2 = xs[i][2];
          u32x4 ov;
          ov.x = cvtpk(w0 * bflo(x0.x) + w1 * bflo(x1.x) + w2 * bflo(x2.x), w0 * bfhi(x0.x) + w1 * bfhi(x1.x) + w2 * bfhi(x2.x));
          ov.y = cvtpk(w0 * bflo(x0.y) + w1 * bflo(x1.y) + w2 * bflo(x2.y), w0 * bfhi(x0.y) + w1 * bfhi(x1.y) + w2 * bfhi(x2.y));
          ov.z = cvtpk(w0 * bflo(x0.z) + w1 * bflo(x1.z) + w2 * bflo(x2.z), w0 * bfhi(x0.z) + w1 * bfhi(x1.z) + w2 * bfhi(x2.z));
          ov.w = cvtpk(w0 * bflo(x0.w) + w1 * bflo(x1.w) + w2 * bflo(x2.w), w0 * bfhi(x0.w) + w1 * bfhi(x1.w) + w2 * bfhi(x2.w));
          *(u32x4*)(O + m * 1024 + 64 * h + ch * 8) = ov; } }
    asm volatile("s_waitcnt vmcnt(0) lgkmcnt(0)\n\ts_barrier" ::: "memory");
#undef ATTB_DMA
#undef ATTB_DMA_K
#undef ATTB_DMA_V
}
__device__ __forceinline__ bool score_bound_ok(const float* g_qb, const float* g_kb) {
    int l_ = threadIdx.x; asm volatile("" : "+v"(l_)); const int l = l_ & 63;
    float gq = fmaxf(fabsf(g_qb[l]), fabsf(g_qb[32 + (l & 31)])); gq = fmaxf(gq, fabsf(g_qb[64 + (l & 31)])); float gk = fmaxf(fabsf(g_kb[l]), fabsf(g_kb[64 + (l & 31)]));
#pragma unroll
    for (int o_ = 1; o_ < 64; o_ <<= 1) { gq = fmaxf(gq, __shfl_xor(gq, o_)); gk = fmaxf(gk, __shfl_xor(gk, o_)); }
    return __builtin_amdgcn_readfirstlane((int)(96.0f * QSCALE_B * gq * gk < 60.0f)) != 0; }
template <int VAR> __device__ __forceinline__ void phase(unsigned char* lds, int vcu, int G, const bf16* Q, const bf16* KN, const bf16* KR, const bf16* V, bf16* O, const float* g_qb, const float2* CS, const bf16* PO, const float2* ML, const bool fast) {
    for (int v = vcu; v < BATCH * HB * 8; v += G) {
        const int bh = v >> 3, s = v & 7;
        unit<VAR>(bh / HB, bh % HB, 15 - s, Q, KN, KR, V, O, (lds_ptr)lds, g_qb, CS, PO, ML, fast);
        unit<VAR>(bh / HB, bh % HB, s, Q, KN, KR, V, O, (lds_ptr)lds, g_qb, CS, PO, ML, fast);
    }
}
#undef ATTB_WAIT_BAR
}
namespace atta {
using namespace attb;
constexpr int BCOPY = 272;
constexpr int L_K = 0, L_V = 6 * 8192, L_BIAS = 12 * 8192, L_ID = L_BIAS + 4 * BCOPY * 4, L_WS = L_ID + 256, L_OST = L_WS + NWAVES * 256, L_BYTES = L_OST + NWAVES * 4096;
constexpr size_t PO_STRIDE = (size_t)M * 512;
constexpr float THR_A = 20.0f;
struct UnitA { int b, h, br, rho, c, dil; long tok0; };
__device__ __forceinline__ UnitA decode(int id) { UnitA u; const int bh = id / 48, r = id % 48, k = r & 15; u.br = r >> 4; u.b = bh >> 3; u.h = bh & 7;
    u.rho = u.br == 0 ? 0 : (u.br == 1 ? (k >> 2) : k); u.c = u.br == 0 ? k : (u.br == 1 ? (k & 3) : 0); u.dil = u.br == 0 ? 1 : (u.br == 1 ? 4 : 16); u.tok0 = (long)u.b * SEQ + u.rho; return u; }
constexpr int NUNITS = 32 * 48;
__device__ __forceinline__ bool score_bound_ok(const float* g_qa, const float* g_ka, const float* RB) {
    int l_ = threadIdx.x; asm volatile("" : "+v"(l_)); const int lane = l_ & 63;
    float gq = fabsf(g_qa[lane]), gk = fabsf(g_ka[lane]), bm = 0.f;
    for (int i = lane; i < 32 * 8; i += 64) bm = fmaxf(bm, fabsf(RB[i]) * LOG2E);
#pragma unroll
    for (int o_ = 1; o_ < 64; o_ <<= 1) { gq = fmaxf(gq, __shfl_xor(gq, o_)); gk = fmaxf(gk, __shfl_xor(gk, o_)); bm = fmaxf(bm, __shfl_xor(bm, o_)); }
    return __builtin_amdgcn_readfirstlane((int)(64.0f * QSCALE_A * gq * gk + bm < 60.0f)) != 0; }
template <int VAR> __device__ __forceinline__ void phase(unsigned char* lds, unsigned* counter, const bf16* Q, const bf16* K, const bf16* V, const float* BT, bf16* PO, float2* ML, const bool fast) {
    lds_ptr shm = (lds_ptr)lds;
    int tid_ = threadIdx.x; asm volatile("" : "+v"(tid_));
    const int tid = tid_, lane = tid & 63, r32 = lane & 31, hi = lane >> 5; const int wid = __builtin_amdgcn_readfirstlane(tid >> 6);
    const unsigned lds0 = (unsigned)(uintptr_t)shm;
    __attribute__((address_space(3))) float* wsf = (__attribute__((address_space(3))) float*)(shm + L_WS) + wid * 64;
    __attribute__((address_space(3))) float* bias = (__attribute__((address_space(3))) float*)(shm + L_BIAS);
    volatile __attribute__((address_space(3))) int* idw = (volatile __attribute__((address_space(3))) int*)(shm + L_ID);
    const lds_cptr kp0 = (lds_cptr)shm + L_K + r32 * 128;
    int koff[4];
#pragma unroll
    for (int d0 = 0; d0 < 4; ++d0) koff[d0] = ((2 * d0 + hi) ^ ((r32 >> 1) & 7)) * 16;
    const lds_cptr vp0 = (lds_cptr)shm + L_V + ((lane >> 4) & 1) * 32 + (lane & 3) * 8 + (4 * hi + ((lane & 15) >> 2)) * 64;
    bf16x8 qr[4];
    bf16x8 qn[4]; float bn[2];
#define ATTA_LOADS(u) do { \
        _Pragma("unroll") for (int e_ = 0; e_ < 2; ++e_) { const int ent_ = tid + 512 * e_, y_ = 255 - ((ent_ & 255) + (ent_ >> 8)) - 64; bn[e_] = (y_ >= 0 && y_ <= 128) ? BT[((u).br * 8 + (u).h) * 132 + y_] : -INFINITY; } \
        { const long qt_ = (u).tok0 + (long)(u).dil * (256 * (u).c + wid * 32 + r32); \
          _Pragma("unroll") for (int d0 = 0; d0 < 4; ++d0) qn[d0] = *reinterpret_cast<const bf16x8*>(Q + qt_ * 512 + 64 * (u).h + d0 * 16 + hi * 8); } } while (0)
#define ATTA_ISSUE(u) do { asm volatile("" : "+v"(qn[0]), "+v"(qn[1]), "+v"(qn[2]), "+v"(qn[3]), "+v"(bn[0]), "+v"(bn[1]));     \
        bias[(tid >> 8) * BCOPY + (tid & 255)] = bn[0]; bias[((tid >> 8) + 2) * BCOPY + (tid & 255)] = bn[1]; \
        _Pragma("unroll") for (int d0 = 0; d0 < 4; ++d0) qr[d0] = qn[d0]; \
        asm volatile("" ::: "memory"); \
        const int tmin_ = ((u).c == 0) ? 2 : 0; const int u0_ = 256 * (u).c - 128; \
        for (int tau = tmin_; tau < 6; ++tau) { const int uk = u0_ + 64 * tau; \
            glds16(K + ((u).tok0 + (long)(u).dil * (uk + wid * 8 + (lane >> 3))) * 512 + 64 * (u).h + (((lane & 7) ^ (((wid * 8 + (lane >> 3)) >> 1) & 7)) * 8), (unsigned)__builtin_amdgcn_readfirstlane(lds0 + L_K + tau * 8192 + wid * 1024)); \
            glds16(V + ((u).tok0 + (long)(u).dil * (uk + 16 * (wid & 3) + (lane >> 2))) * 512 + 64 * (u).h + (wid >> 2) * 32 + (lane & 3) * 8, (unsigned)__builtin_amdgcn_readfirstlane(lds0 + L_V + tau * 8192 + wid * 1024)); } } while (0)
    if (tid == 0) idw[0] = (int)__hip_atomic_fetch_add(counter, 1u, __ATOMIC_RELAXED, __HIP_MEMORY_SCOPE_AGENT);
    asm volatile("s_waitcnt vmcnt(0) lgkmcnt(0)\n\ts_barrier" ::: "memory");
    int id = __builtin_amdgcn_readfirstlane(idw[0]), par = 0;
    if (id >= NUNITS) return;
    UnitA u = decode(id);
    ATTA_LOADS(u); ATTA_ISSUE(u);
    for (;;) {
        if (tid == 0) idw[par ^ 1] = (int)__hip_atomic_fetch_add(counter, 1u, __ATOMIC_RELAXED, __HIP_MEMORY_SCOPE_AGENT);
        float mhat = 0.f, l_run = 0.f; f32x16 o[2]; o[0] = f32x16{}; o[1] = f32x16{}; f32x16 negm = f32x16{}; asm volatile("" : "+v"(negm));
        const int tau_min = (u.c == 0) ? 2 : 0;
        asm volatile("s_waitcnt vmcnt(0) lgkmcnt(0)\n\ts_barrier" ::: "memory");
        const int nid = __builtin_amdgcn_readfirstlane(idw[par ^ 1]); par ^= 1;
        const bool more = nid < NUNITS;
        UnitA nu = u; if (more) { nu = decode(nid); ATTA_LOADS(nu); }
        const __attribute__((address_space(3))) f32x4* biasv;
        { const int A0 = 63 - 32 * (wid & 1) - r32 + 4 * hi; biasv = (const __attribute__((address_space(3))) f32x4*)(bias + BCOPY * (A0 & 3) + (A0 & ~3)); }
        if (fast && (wid >> 1) >= tau_min) {
#define ATTA_FQK(PN0, PN1, ii) do { const lds_cptr kp = kp0 + ((wid >> 1) + (ii)) * 8192; \
            bf16x8 kf[8]; \
            _Pragma("unroll") for (int d0 = 0; d0 < 4; ++d0) { kf[2 * d0] = *(const __attribute__((address_space(3))) bf16x8*)(kp + koff[d0]); kf[2 * d0 + 1] = *(const __attribute__((address_space(3))) bf16x8*)(kp + koff[d0] + 4096); } \
            PN0 = __builtin_amdgcn_mfma_f32_32x32x16_bf16(kf[0], qr[0], zero16, 0, 0, 0); PN1 = __builtin_amdgcn_mfma_f32_32x32x16_bf16(kf[1], qr[0], zero16, 0, 0, 0); \
            _Pragma("unroll") for (int d0 = 1; d0 < 4; ++d0) { PN0 = __builtin_amdgcn_mfma_f32_32x32x16_bf16(kf[2 * d0], qr[d0], PN0, 0, 0, 0); PN1 = __builtin_amdgcn_mfma_f32_32x32x16_bf16(kf[2 * d0 + 1], qr[d0], PN1, 0, 0, 0); } } while (0)
#define ATTA_FBEXP(PN0, PN1, ii) do { const __attribute__((address_space(3))) f32x4* bp = biasv + 16 * (ii); \
            _Pragma("unroll") for (int g = 0; g < 4; ++g) { const f32x4 b0 = bp[2 * g], b1 = bp[2 * g + 8]; \
                _Pragma("unroll") for (int e = 0; e < 4; ++e) { PN0[4 * g + e] = __builtin_amdgcn_exp2f(PN0[4 * g + e] + b0[e]); PN1[4 * g + e] = __builtin_amdgcn_exp2f(PN1[4 * g + e] + b1[e]); } } } while (0)
#define ATTA_FSUMPACK(PC0, PC1) do { l_run += rowsum32(PC0, PC1); \
            _Pragma("unroll") for (int k = 0; k < 2; ++k) { pw[k] = (u32x4){cvtpk(PC0[8 * k], PC0[8 * k + 1]), cvtpk(PC0[8 * k + 2], PC0[8 * k + 3]), cvtpk(PC0[8 * k + 4], PC0[8 * k + 5]), cvtpk(PC0[8 * k + 6], PC0[8 * k + 7])}; \
                pw[2 + k] = (u32x4){cvtpk(PC1[8 * k], PC1[8 * k + 1]), cvtpk(PC1[8 * k + 2], PC1[8 * k + 3]), cvtpk(PC1[8 * k + 4], PC1[8 * k + 5]), cvtpk(PC1[8 * k + 6], PC1[8 * k + 7])}; } } while (0)
#define ATTA_FPV(ii) do { const lds_cptr vp = (lds_cptr)(uintptr_t)(((unsigned)(uintptr_t)(vp0 + ((wid >> 1) + (ii)) * 8192)) & 0x3ffffu); \
            _Pragma("unroll") for (int ks = 0; ks < 4; ++ks) \
                _Pragma("unroll") for (int d0 = 0; d0 < 2; ++d0) { \
                    const s16x4 lo = vtr(vp + d0 * 4096 + ks * 1024), hh = vtr(vp + d0 * 4096 + ks * 1024 + 512); \
                    const bf16x8 vf = (bf16x8){lo[0], lo[1], lo[2], lo[3], hh[0], hh[1], hh[2], hh[3]}; \
                    o[d0] = __builtin_amdgcn_mfma_f32_32x32x16_bf16(__builtin_bit_cast(bf16x8, pw[ks]), vf, o[d0], 0, 0, 0); } } while (0)
            const f32x16 zero16 = f32x16{}; f32x16 pa0, pa1, pb0, pb1; u32x4 pw[4];
            ATTA_FQK(pa0, pa1, 0); ATTA_FBEXP(pa0, pa1, 0);
            ATTA_FQK(pb0, pb1, 1); ATTA_FSUMPACK(pa0, pa1); ATTA_FPV(0); ATTA_FBEXP(pb0, pb1, 1);
            ATTA_FQK(pa0, pa1, 2); ATTA_FSUMPACK(pb0, pb1); ATTA_FPV(1); ATTA_FBEXP(pa0, pa1, 2);
            ATTA_FSUMPACK(pa0, pa1); ATTA_FPV(2);
#undef ATTA_FQK
#undef ATTA_FBEXP
#undef ATTA_FSUMPACK
#undef ATTA_FPV
        } else
        for (int i = 0; i < 3; ++i) {
            const int tau = (wid >> 1) + i;
            if (tau < tau_min) continue;
            const lds_cptr kp = kp0 + tau * 8192; const lds_cptr vp = vp0 + tau * 8192;
            f32x16 p0, p1;
            { bf16x8 kf[8];
#pragma unroll
              for (int d0 = 0; d0 < 4; ++d0) { kf[2 * d0] = *(const __attribute__((address_space(3))) bf16x8*)(kp + koff[d0]); kf[2 * d0 + 1] = *(const __attribute__((address_space(3))) bf16x8*)(kp + koff[d0] + 4096); }
              __builtin_amdgcn_sched_barrier(0);
              p0 = __builtin_amdgcn_mfma_f32_32x32x16_bf16(kf[0], qr[0], negm, 0, 0, 0); p1 = __builtin_amdgcn_mfma_f32_32x32x16_bf16(kf[1], qr[0], negm, 0, 0, 0);
#pragma unroll
              for (int d0 = 1; d0 < 4; ++d0) { p0 = __builtin_amdgcn_mfma_f32_32x32x16_bf16(kf[2 * d0], qr[d0], p0, 0, 0, 0); p1 = __builtin_amdgcn_mfma_f32_32x32x16_bf16(kf[2 * d0 + 1], qr[d0], p1, 0, 0, 0); }
              __builtin_amdgcn_sched_barrier(0); }
            { const __attribute__((address_space(3))) f32x4* bp = biasv + 16 * i;
#pragma unroll
              for (int g = 0; g < 4; ++g) { const f32x4 b0 = bp[2 * g], b1 = bp[2 * g + 8];
#pragma unroll
                  for (int e = 0; e < 4; ++e) { p0[4 * g + e] += b0[e]; p1[4 * g + e] += b1[e]; } } }
            const float rm = rowmax32(p0, p1);
            if (__any(rm > THR_A)) {
                const float dl = fmaxf(rm, 0.f), f = __builtin_amdgcn_exp2f(-dl);
                mhat += dl; l_run *= f;
#pragma unroll
                for (int r = 0; r < 16; ++r) { p0[r] -= dl; p1[r] -= dl; negm[r] = -mhat; }
                asm volatile("" : "+v"(negm));
                if (hi == 0) wsf[r32] = f;
                asm volatile("s_waitcnt lgkmcnt(0)" ::: "memory");
#pragma unroll
                for (int r = 0; r < 16; ++r) { const float fr = wsf[crow(r, hi)]; o[0][r] *= fr; o[1][r] *= fr; }
            }
#pragma unroll
            for (int r = 0; r < 16; ++r) { p0[r] = __builtin_amdgcn_exp2f(p0[r]); p1[r] = __builtin_amdgcn_exp2f(p1[r]); }
            l_run += rowsum32(p0, p1);
            u32x4 pw[4];
#pragma unroll
            for (int k = 0; k < 2; ++k) { pw[k] = (u32x4){cvtpk(p0[8 * k], p0[8 * k + 1]), cvtpk(p0[8 * k + 2], p0[8 * k + 3]), cvtpk(p0[8 * k + 4], p0[8 * k + 5]), cvtpk(p0[8 * k + 6], p0[8 * k + 7])};
                pw[2 + k] = (u32x4){cvtpk(p1[8 * k], p1[8 * k + 1]), cvtpk(p1[8 * k + 2], p1[8 * k + 3]), cvtpk(p1[8 * k + 4], p1[8 * k + 5]), cvtpk(p1[8 * k + 6], p1[8 * k + 7])}; }
            { s16x4 vl[8], vh[8];
#pragma unroll
              for (int i2 = 0; i2 < 8; ++i2) { vl[i2] = vtr(vp + (i2 >> 2) * 4096 + (i2 & 3) * 1024); vh[i2] = vtr(vp + (i2 >> 2) * 4096 + (i2 & 3) * 1024 + 512); }
              __builtin_amdgcn_sched_barrier(0);
#pragma unroll
              for (int ks = 0; ks < 4; ++ks)
#pragma unroll
                  for (int d0 = 0; d0 < 2; ++d0) { const int i2 = 4 * d0 + ks;
                      const bf16x8 vf = (bf16x8){vl[i2][0], vl[i2][1], vl[i2][2], vl[i2][3], vh[i2][0], vh[i2][1], vh[i2][2], vh[i2][3]};
                      o[d0] = __builtin_amdgcn_mfma_f32_32x32x16_bf16(__builtin_bit_cast(bf16x8, pw[ks]), vf, o[d0], 0, 0, 0); }
              __builtin_amdgcn_sched_barrier(0); }
        }
        asm volatile("s_waitcnt vmcnt(0) lgkmcnt(0)\n\ts_barrier" ::: "memory");
        const UnitA cu = u;
        if (more) { u = nu; ATTA_ISSUE(u); }
        const long qtok = cu.tok0 + (long)cu.dil * (256 * cu.c + wid * 32 + r32);
        { auto rr = __builtin_amdgcn_permlane32_swap(__float_as_uint(l_run), __float_as_uint(l_run), false, false); l_run = __uint_as_float(rr[0]) + __uint_as_float(rr[1]); }
        if (hi == 0) { wsf[32 + r32] = l_run; ML[((size_t)cu.br * M + qtok) * 8 + cu.h] = make_float2(mhat, l_run); }
        asm volatile("s_waitcnt lgkmcnt(0)" ::: "memory");
        float rli[16];
#pragma unroll
        for (int r = 0; r < 16; ++r) rli[r] = 1.0f / wsf[32 + crow(r, hi)];
        { __attribute__((address_space(3))) bf16* stg = (__attribute__((address_space(3))) bf16*)(shm + L_OST) + wid * 2048;
#pragma unroll
          for (int r = 0; r < 16; ++r) { const int orow = crow(r, hi);
#pragma unroll
              for (int d0 = 0; d0 < 2; ++d0) stg[orow * 64 + d0 * 32 + r32] = (bf16)f2bf(o[d0][r] * rli[r]); }
          asm volatile("s_waitcnt lgkmcnt(0)" ::: "memory");
          bf16* Pb = PO + (size_t)cu.br * PO_STRIDE + 64 * cu.h;
#pragma unroll
          for (int i = 0; i < 4; ++i) { const int row = i * 8 + (lane >> 3), ch = lane & 7; const u32x4 v = *(const __attribute__((address_space(3))) u32x4*)(stg + row * 64 + ch * 8);
              *(u32x4*)(Pb + (cu.tok0 + (long)cu.dil * (256 * cu.c + wid * 32 + row)) * 512 + ch * 8) = v; } }
        if (!more) break;
    }
    asm volatile("s_waitcnt vmcnt(0) lgkmcnt(0)\n\ts_barrier" ::: "memory");
#undef ATTA_LOADS
#undef ATTA_ISSUE
}
}
constexpr int PER_PHASE = 8;
constexpr int N_LAUNCHES = MK_N_LAUNCHES;
struct Args { const void* in[17]; float* out; unsigned char* ws; int ph_lo, ph_hi, li, pad; };
__global__ void __launch_bounds__(NWAVES * 64, 2) fwd_kernel(Args args) {
    extern __shared__ __attribute__((aligned(16))) unsigned char lds[];
    Frame F;
    F.lds = (LAS unsigned char*)lds;
    F.MISC = (volatile LAS unsigned*)(F.lds + MISC_OFF);
    F.tid = threadIdx.x; F.lane = F.tid & 63; F.wave = __builtin_amdgcn_readfirstlane(F.tid >> 6);
    F.G = gridDim.x; { const int bx = blockIdx.x; F.vcu = (F.G % 8 == 0) ? (bx % 8) * (F.G / 8) + bx / 8 : bx; }
    unsigned char* ws = args.ws;
    F.ctl = (gu32*)(ws + WS_CTL);
    In I; I.x = (const float*)args.in[0]; I.pos = (const int*)args.in[1]; I.g_mix = (const float*)args.in[2]; I.w_in = (const float*)args.in[3]; I.g_qa = (const float*)args.in[4]; I.g_ka = (const float*)args.in[5];
    I.rel_bias = (const float*)args.in[6]; I.g_cq = (const float*)args.in[7]; I.g_ckv = (const float*)args.in[8]; I.w_uq = (const float*)args.in[9]; I.w_ukv = (const float*)args.in[10]; I.g_qb = (const float*)args.in[11];
    I.g_kb = (const float*)args.in[12]; I.w_o = (const float*)args.in[13]; I.g_ffn = (const float*)args.in[14]; I.w1 = (const float*)args.in[15]; I.w2 = (const float*)args.in[16];
    for (int u = F.tid; u < (LDS_BYTES - LDSCTL_OFF) / 4; u += NWAVES * 64) ((LAS unsigned*)(F.lds + LDSCTL_OFF))[u] = 0u;
    __syncthreads();
    XcdBarrier bar; bar.bar = (unsigned*)(F.ctl + CW_BAR); bar.x = 0; bar.st = nullptr;
    if (N_LAUNCHES != PER_PHASE) bar = xcd_barrier_post((unsigned*)(F.ctl + CW_BAR), F.MISC + 8);
#define GRID_BAR() do { if (N_LAUNCHES != PER_PHASE) xcd_barrier(bar); } while (0)
    const int lo = args.ph_lo, hi = args.ph_hi;
#define IN(k) (lo <= (k) && (k) < hi)
#define BOTH(k) (IN(k) && IN((k) + 1))
    bf16* XN = (bf16*)(ws + WS_XN);
    int sbA = -1, sbB = -1;
    if (IN(0)) { p0_prologue(F, I, ws); if (BOTH(0)) GRID_BAR(); }
    if (IN(1)) {
        pg8::Gemm g{XN, (const bf16*)(ws + WS_WIN), M, NIN_PAD, D}; pg8::StaticOrder S; S.init(M, NIN_PAD, F.G, (int)blockIdx.x);
        pg8::EpiInProj E{(bf16*)(ws + WS_QA), (bf16*)(ws + WS_KA), (bf16*)(ws + WS_VA), (bf16*)(ws + WS_CQ), (bf16*)(ws + WS_CKV), (float*)(ws + WS_KR), (float*)(ws + WS_SSQCQ), (float*)(ws + WS_SSQCKV), (float*)(ws + WS_SKR),
                         I.g_qa, I.g_ka, I.g_kb, (const float2*)(ws + WS_CS), QSCALE_A};
        const int nidle = F.G - (NIN_PAD / 256 * (M / 256)) % F.G, first = F.G - nidle; const bool filler = nidle < F.G && (int)blockIdx.x >= first;
        if (filler) { p0b_items(F, I, ws, ((int)blockIdx.x - first) * NWAVES + F.wave, nidle * NWAVES, 3); __syncthreads(); }
        pg8::gemm_phase<pg8::EpiInProj, pg8::StaticOrder, PG8_ALIGN, PG8_SP2>(F.lds + RING_OFF, g, S, E);
        if (filler) p0b_items(F, I, ws, ((int)blockIdx.x - first) * NWAVES + F.wave, nidle * NWAVES, 4);
        else if (nidle >= F.G) p0b_items(F, I, ws, F.vcu * NWAVES + F.wave, F.G * NWAVES, 0);
        if (BOTH(1)) { sbA = atta::score_bound_ok(I.g_qa, I.g_ka, I.rel_bias) ? 1 : 0; sbB = attb::score_bound_ok(I.g_qb, I.g_kb) ? 1 : 0; GRID_BAR(); }
    }
    if (IN(2)) {
        { pg8::Gemm g{(const bf16*)(ws + WS_CQ), (const bf16*)(ws + WS_WUQ), M, 768, QLR}; pg8::StaticOrder S; S.init(M, 768, F.G, (int)blockIdx.x);
          pg8::EpiRowScale<12, 768> E{(const float*)(ws + WS_SSQCQ), (bf16*)(ws + WS_QB), 768};
          pg8::gemm_phase<pg8::EpiRowScale<12, 768>, pg8::StaticOrder, PG8_ALIGN, PG8_SP2>(F.lds + RING_OFF, g, S, E);
        }
        { pg8::Gemm g{(const bf16*)(ws + WS_CKV), (const bf16*)(ws + WS_WUKV), M, 1024, KVLR}; pg8::StaticOrder S; S.init(M, 1024, F.G, (int)blockIdx.x);
          pg8::EpiKV E{(const float*)(ws + WS_SSQCKV), (const float*)(ws + WS_SKR), (const float*)(ws + WS_KR), I.g_kb, (bf16*)(ws + WS_KBN), (bf16*)(ws + WS_KBR), (bf16*)(ws + WS_VB)};
          pg8::gemm_phase<pg8::EpiKV, pg8::StaticOrder, PG8_ALIGN, PG8_SP2>(F.lds + RING_OFF, g, S, E);
        }
        atta::phase<0>(lds, (unsigned*)(F.ctl + CW_AQ), (const bf16*)(ws + WS_QA), (const bf16*)(ws + WS_KA), (const bf16*)(ws + WS_VA), (const float*)(ws + WS_BIAS), (bf16*)args.out, (float2*)(ws + WS_ML), (sbA < 0 ? atta::score_bound_ok(I.g_qa, I.g_ka, I.rel_bias) : sbA != 0));
        if (BOTH(2)) GRID_BAR();
    }
    if (IN(4)) {
        attb::phase<0>(lds, F.vcu, F.G, (const bf16*)(ws + WS_QB), (const bf16*)(ws + WS_KBN), (const bf16*)(ws + WS_KBR), (const bf16*)(ws + WS_VB), (bf16*)(ws + WS_MIX), I.g_qb, (const float2*)(ws + WS_CS), (const bf16*)args.out, (const float2*)(ws + WS_ML), (sbB < 0 ? attb::score_bound_ok(I.g_qb, I.g_kb) : sbB != 0));
        if (BOTH(4)) GRID_BAR(); }
    if (IN(5)) {
        pg8::Gemm g{(const bf16*)(ws + WS_MIX), (const bf16*)(ws + WS_WO), M, D, D}; pg8::StaticOrder S; S.init(M, D, F.G, (int)blockIdx.x);
        pg8::EpiWo E{I.x, args.out, (bf16*)(ws + WS_H1B), (float*)(ws + WS_SSQH), D};
        pg8::gemm_phase<pg8::EpiWo, pg8::StaticOrder, PG8_ALIGN, PG8_SP2>(F.lds + RING_OFF, g, S, E);
        if (BOTH(5)) GRID_BAR();
    }
    if (IN(6)) {
        { const int grp = F.vcu & 3;
          if (grp) { LAS float* scr = (LAS float*)(F.lds + RING_OFF + F.wave * 16384); bf16* W2 = (bf16*)(ws + WS_W2);
              const int ngw = ((F.G - grp + 3) >> 2) * NWAVES, gw = (F.vcu >> 2) * NWAVES + F.wave;
              const int lo = grp == 1 ? 0 : (grp == 2 ? I_2 / 4 : I_2 / 2), hi = grp == 1 ? I_2 / 4 : (grp == 2 ? I_2 / 2 : I_2);
              for (int it = lo + gw; it < hi; it += ngw) p0_transpose_item<0>(I.w2, FF, D, W2, nullptr, scr, it, F.lane);
              if (grp == 2) { for (int k = 0; k < 40; ++k) __builtin_amdgcn_s_sleep(2); }
              if (grp == 3) { for (int k = 0; k < 24; ++k) __builtin_amdgcn_s_sleep(2); }
              __syncthreads(); } }
        pg8::Gemm g{(const bf16*)(ws + WS_H1B), (const bf16*)(ws + WS_W1), M, FF, D}; pg8::StaticOrder S; S.init(M, FF, F.G, (int)blockIdx.x);
        pg8::EpiRelu2 E{(const float*)(ws + WS_SSQH), (bf16*)(ws + WS_HID), FF};
        pg8::gemm_phase<pg8::EpiRelu2, pg8::StaticOrder, PG8_ALIGN, PG8_SP2>(F.lds + RING_OFF, g, S, E);
        if (BOTH(6)) GRID_BAR();
    }
    if (IN(7)) {
        pg8::Gemm g{(const bf16*)(ws + WS_HID), (const bf16*)(ws + WS_W2), M, D, FF}; pg8::StaticOrder S; S.init(M, D, F.G, (int)blockIdx.x);
        pg8::EpiF32ResB E{(const bf16*)(ws + WS_H1B), args.out, D};
        pg8::gemm_phase<pg8::EpiF32ResB, pg8::StaticOrder, PG8_ALIGN, PG8_SP2>(F.lds + RING_OFF, g, S, E);
    }
#undef IN
#undef BOTH
}

extern "C" void kernel_launch(void* const* d_in, const int* in_sizes, int n_in, void* d_out, int out_size, void* d_ws, size_t ws_size, hipStream_t stream) {
    static int grid = 0;
    if (grid == 0) {
        if (n_in != 17 || out_size != M * D || ws_size < WS_END) { fprintf(stderr, "kernel_launch: unexpected problem shape (n_in %d out %d ws %zu)\n", n_in, out_size, ws_size); grid = -1; return; }
        int dev = 0, cus = 0, per_cu = 0;
        if (hipGetDevice(&dev) != hipSuccess || hipDeviceGetAttribute(&cus, hipDeviceAttributeMultiprocessorCount, dev) != hipSuccess) { grid = -1; return; }
        if (hipFuncSetAttribute((const void*)fwd_kernel, hipFuncAttributeMaxDynamicSharedMemorySize, LDS_BYTES) != hipSuccess) { fprintf(stderr, "kernel_launch: hipFuncSetAttribute failed\n"); grid = -1; return; }
        if (hipOccupancyMaxActiveBlocksPerMultiprocessor(&per_cu, (const void*)fwd_kernel, NWAVES * 64, LDS_BYTES) != hipSuccess || per_cu < 1) { fprintf(stderr, "kernel_launch: occupancy query says %d\n", per_cu); (void)hipGetLastError(); grid = -1; return; }
        grid = cus;
    }
    if (grid < 0) return;
    (void)hipMemsetAsync((char*)d_ws + WS_CTL, 0, CTL_ZERO_BYTES, stream);
    Args a{};
    for (int i = 0; i < 17; ++i) a.in[i] = d_in[i];
    a.out = (float*)d_out; a.ws = (unsigned char*)d_ws;
    if (N_LAUNCHES == 1) { a.ph_lo = 0; a.ph_hi = PER_PHASE; a.li = 0; hipLaunchKernelGGL(fwd_kernel, dim3(grid), dim3(NWAVES * 64), LDS_BYTES, stream, a); }
    else for (int li = 0; li < PER_PHASE; ++li) { a.ph_lo = li; a.ph_hi = li + 1; a.li = li; hipLaunchKernelGGL(fwd_kernel, dim3(grid), dim3(NWAVES * 64), LDS_BYTES, stream, a); }
}
```

```cpp
#include <hip/hip_runtime.h>
#include <cstdio>
#include <cstdint>
namespace pg8 {
#define PG8_LAS __attribute__((address_space(3)))
typedef unsigned short bf16_t;
typedef short bf16x8 __attribute__((ext_vector_type(8)));
typedef float f32x4 __attribute__((ext_vector_type(4)));
typedef unsigned u32x4 __attribute__((ext_vector_type(4)));
constexpr int BM = 256, BK = 64, HALF = 128, HTB = HALF * BK * 2  , STAGE_BYTES = 8 * HTB, NXCD = 8, WGM = 8;

__host__ __device__ __forceinline__ int lds_byte(int r, int c) { const int st = (r >> 4) * 2 + (c >> 5), rr = r & 15, cc = c & 31, ob = rr * 64 + cc * 2; return st * 1024 + (ob ^ (((ob >> 9) & 1) << 5)); }
__host__ __device__ __forceinline__ void stage_rc(int b, int& R, int& C) { const int st = b / 1024, sb = b % 1024, swz = sb ^ (((sb >> 9) & 1) << 5); R = (st >> 1) * 16 + swz / 64; C = (st & 1) * 32 + (swz % 64) / 2; }
__host__ __device__ __forceinline__ int perm32(int rho) { const int n = rho >> 4, i = rho & 15; return 8 * (i >> 2) + 4 * n + (i & 3); }

struct Unit { int pm, pn; };
struct Gemm { const bf16_t* A; const bf16_t* Bt; int M, N, K; };

struct StaticOrder {
    int nM, nN, nwg, G, c;
    __host__ __device__ void init(int M, int N, int G_, int c_) { nM = M / BM; nN = N / BM; nwg = nM * nN; G = G_; c = c_; }
    __host__ __device__ bool next(int i, Unit& u) const {
        const long L = (long)i * G + c; if (L >= nwg) return false;
        int wgid = (int)L; { const int q = nwg / NXCD, r = nwg % NXCD, xcd = wgid % NXCD, off = wgid / NXCD; wgid = (xcd < r ? xcd * (q + 1) : r * (q + 1) + (xcd - r) * q) + off; }
        const int nig = WGM * nN, gid = wgid / nig, fm = gid * WGM, gsz = (nM - fm) < WGM ? (nM - fm) : WGM;
        u.pm = fm + ((wgid % nig) % gsz); u.pn = (wgid % nig) / gsz; return true;
    }
    __device__ __forceinline__ void a_ready(const Unit&) const {}
    __device__ __forceinline__ void done(const Unit&) const {}
};

__device__ __forceinline__ unsigned cvt_pk_bf16(float lo, float hi) { unsigned r; asm volatile("v_cvt_pk_bf16_f32 %0, %1, %2" : "=v"(r) : "v"(lo), "v"(hi)); return r; }
__device__ __forceinline__ u32x4 pack8(const f32x4 v0, const f32x4 v1) { u32x4 w; w.x = cvt_pk_bf16(v0[0], v0[1]); w.y = cvt_pk_bf16(v0[2], v0[3]); w.z = cvt_pk_bf16(v1[0], v1[1]); w.w = cvt_pk_bf16(v1[2], v1[3]); return w; }

struct EpiInProj {
    static constexpr bool PERM = true, AFTER_DRAIN = false; static constexpr int RELAX_STORES = 0;
    bf16_t *QA, *KA, *VA, *CQ, *CKV; float *KR, *SSQ_CQ, *SSQ_CKV, *SKR; const float *g_qa, *g_ka, *g_kb; const float2* CS; float qscale;
    __device__ __forceinline__ void operator()(const f32x4 (&acc)[2][2][4][2], const Unit& u, int wr, int wc, int fr_, int fq_) const {
        int fr = fr_, fq = fq_; asm volatile("" : "+v"(fr), "+v"(fq));
        const int pn = u.pn; const int row0 = u.pm * BM + wr * 64 + fr;
        if (pn < 4) {
            const bool isq = pn < 2; bf16_t* base = (isq ? QA : KA) + 256 * (pn & 1) + 64 * wc + 8 * fq; const float* g = (isq ? g_qa : g_ka) + 8 * fq; const float sc = isq ? qscale : 1.0f;
            f32x4 gv[2][2];
#pragma unroll
            for (int bj = 0; bj < 2; ++bj)
#pragma unroll
                for (int n = 0; n < 2; ++n) gv[bj][n] = *(const f32x4*)(g + 32 * bj + 4 * n) * sc;
#pragma unroll
            for (int ai = 0; ai < 2; ++ai)
#pragma unroll
                for (int m = 0; m < 4; ++m) { float ss = 0.f;
#pragma unroll
                    for (int bj = 0; bj < 2; ++bj)
#pragma unroll
                        for (int n = 0; n < 2; ++n) { const f32x4 x = acc[ai][bj][m][n]; ss += (x[0] * x[0] + x[1] * x[1]) + (x[2] * x[2] + x[3] * x[3]); }
                    ss += __shfl_xor(ss, 16); ss += __shfl_xor(ss, 32);
                    const float rstd = 1.0f / sqrtf(ss * (1.0f / 64.0f) + 1e-6f);
                    bf16_t* rowp = base + (size_t)(row0 + ai * HALF + m * 16) * 512;
#pragma unroll
                    for (int bj = 0; bj < 2; ++bj) *(u32x4*)(rowp + 32 * bj) = pack8(acc[ai][bj][m][0] * rstd * gv[bj][0], acc[ai][bj][m][1] * rstd * gv[bj][1]); }
        } else if (pn < 10) {
            bf16_t* base; int ldc; float* ssq = nullptr; int sld = 0;
            if (pn < 6) { base = VA + 256 * (pn - 4); ldc = 512; } else if (pn < 9) { base = CQ + 256 * (pn - 6); ldc = 768; ssq = SSQ_CQ + 4 * (pn - 6) + wc; sld = 12; } else { base = CKV; ldc = 256; ssq = SSQ_CKV + wc; sld = 4; }
            base += 64 * wc + 8 * fq;
#pragma unroll
            for (int ai = 0; ai < 2; ++ai)
#pragma unroll
                for (int m = 0; m < 4; ++m) { const int row = row0 + ai * HALF + m * 16; bf16_t* rowp = base + (size_t)row * ldc;
#pragma unroll
                    for (int bj = 0; bj < 2; ++bj) *(u32x4*)(rowp + 32 * bj) = pack8(acc[ai][bj][m][0], acc[ai][bj][m][1]);
                    if (ssq) { float ss = 0.f;
#pragma unroll
                        for (int bj = 0; bj < 2; ++bj)
#pragma unroll
                            for (int n = 0; n < 2; ++n) { const f32x4 x = acc[ai][bj][m][n]; ss += (x[0] * x[0] + x[1] * x[1]) + (x[2] * x[2] + x[3] * x[3]); }
                        ss += __shfl_xor(ss, 16); ss += __shfl_xor(ss, 32);
                        if (fq == 0) ssq[(size_t)row * sld] = ss; } }
        } else if (wc == 0) {
            const int d0 = 8 * fq;
#pragma unroll
            for (int ai = 0; ai < 2; ++ai)
#pragma unroll
                for (int m = 0; m < 4; ++m) { const int row = row0 + ai * HALF + m * 16; float ss = 0.f;
#pragma unroll
                    for (int bj = 0; bj < 2; ++bj)
#pragma unroll
                        for (int n = 0; n < 2; ++n) { const f32x4 x = acc[ai][bj][m][n]; ss += (x[0] * x[0] + x[1] * x[1]) + (x[2] * x[2] + x[3] * x[3]); }
                    if (fq >= 2) ss = 0.f;
                    ss += __shfl_xor(ss, 16); ss += __shfl_xor(ss, 32);
                    if (fq == 0) SKR[row] = ss;
                    if (fq < 2) {
#pragma unroll
                        for (int n = 0; n < 2; ++n) { const f32x4 g1 = *(const f32x4*)(g_kb + 64 + d0 + 4 * n), g2 = *(const f32x4*)(g_kb + 80 + d0 + 4 * n);
                            const f32x4 y1 = acc[ai][0][m][n] * g1, y2 = acc[ai][1][m][n] * g2; f32x4 o1, o2;
#pragma unroll
                            for (int i = 0; i < 4; ++i) { const float2 cs = CS[(size_t)row * 16 + d0 + 4 * n + i]; o1[i] = y1[i] * cs.x - y2[i] * cs.y; o2[i] = y2[i] * cs.x + y1[i] * cs.y; }
                            *(f32x4*)(KR + (size_t)row * 32 + d0 + 4 * n) = o1; *(f32x4*)(KR + (size_t)row * 32 + 16 + d0 + 4 * n) = o2; } } }
        }
    }
};
struct EpiWo {
    static constexpr bool PERM = true, AFTER_DRAIN = false; static constexpr int RELAX_STORES = 0;
    const float* base; float* out; bf16_t* H1B; float* SSQ; int ldc;
    __device__ __forceinline__ void operator()(const f32x4 (&acc)[2][2][4][2], const Unit& u, int wr, int wc, int fr_, int fq_) const {
        int fr = fr_, fq = fq_; asm volatile("" : "+v"(fr), "+v"(fq));
        const int row0 = u.pm * BM + wr * 64 + fr, col0 = u.pn * BM + wc * 32 + 8 * fq;
#pragma unroll
        for (int ai = 0; ai < 2; ++ai) {
            f32x4 xb[4][2][2];
#pragma unroll
            for (int m = 0; m < 4; ++m)
#pragma unroll
                for (int bj = 0; bj < 2; ++bj) { const float* p = base + (size_t)(row0 + ai * HALF + m * 16) * ldc + col0 + bj * HALF; xb[m][bj][0] = *(const f32x4*)p; xb[m][bj][1] = *(const f32x4*)(p + 4); }
            asm volatile("" ::: "memory");
#pragma unroll
            for (int m = 0; m < 4; ++m) { const int row = row0 + ai * HALF + m * 16; const size_t off = (size_t)row * ldc + col0; float ss = 0.f;
#pragma unroll
                for (int bj = 0; bj < 2; ++bj) { const f32x4 h0 = xb[m][bj][0] + acc[ai][bj][m][0], h1 = xb[m][bj][1] + acc[ai][bj][m][1];
                    *(u32x4*)(H1B + off + bj * HALF) = pack8(h0, h1);
                    ss += (h0[0] * h0[0] + h0[1] * h0[1]) + (h0[2] * h0[2] + h0[3] * h0[3]) + (h1[0] * h1[0] + h1[1] * h1[1]) + (h1[2] * h1[2] + h1[3] * h1[3]); }
                ss += __shfl_xor(ss, 16); ss += __shfl_xor(ss, 32);
                if (fq == 0) SSQ[(size_t)row * 16 + 4 * u.pn + wc] = ss; }
            asm volatile("" ::: "memory");
        }
    }
};
template <int NS, int KD> __device__ __forceinline__ float rstd_slots(const float* ssq, int row) {
    const f32x4* sp = (const f32x4*)(ssq + (size_t)row * NS); f32x4 s4 = sp[0];
#pragma unroll
    for (int i = 1; i < NS / 4; ++i) s4 += sp[i];
    return 1.0f / sqrtf(((s4[0] + s4[1]) + (s4[2] + s4[3])) * (1.0f / (float)KD) + 1e-6f);
}
template <int NS, int KD> __device__ __forceinline__ void rstd_rows8(const float* ssq, int row0, int fr, int fq, float (&rs)[2][4]) {
    float own[2];
#pragma unroll
    for (int ai = 0; ai < 2; ++ai) own[ai] = rstd_slots<NS, KD>(ssq, row0 + ai * HALF + fq * 16);
    const int l15 = fr;
#pragma unroll
    for (int ai = 0; ai < 2; ++ai)
#pragma unroll
        for (int m = 0; m < 4; ++m) rs[ai][m] = __shfl(own[ai], l15 + 16 * m);
}
template <int NS, int KD> struct EpiRowScale {
    static constexpr bool PERM = true, AFTER_DRAIN = false; static constexpr int RELAX_STORES = 0;
    const float* ssq; bf16_t* O; int ldc;
    __device__ __forceinline__ void operator()(const f32x4 (&acc)[2][2][4][2], const Unit& u, int wr, int wc, int fr_, int fq_) const {
        int fr = fr_, fq = fq_; asm volatile("" : "+v"(fr), "+v"(fq));
        const int row0 = u.pm * BM + wr * 64 + fr, col0 = u.pn * BM + wc * 32 + 8 * fq;
        float rs[2][4]; rstd_rows8<NS, KD>(ssq, row0, fr, fq, rs);
#pragma unroll
        for (int ai = 0; ai < 2; ++ai)
#pragma unroll
            for (int m = 0; m < 4; ++m) { const int row = row0 + ai * HALF + m * 16; const float s = rs[ai][m]; bf16_t* rowp = O + (size_t)row * ldc + col0;
#pragma unroll
                for (int bj = 0; bj < 2; ++bj) *(u32x4*)(rowp + bj * HALF) = pack8(acc[ai][bj][m][0] * s, acc[ai][bj][m][1] * s); }
    }
};
struct EpiKV {
    static constexpr bool PERM = true, AFTER_DRAIN = false; static constexpr int RELAX_STORES = 0;
    const float *SSQ_CKV, *SKR, *KR, *g_kb; bf16_t *KBN, *KBR, *VB;
    __device__ __forceinline__ void operator()(const f32x4 (&acc)[2][2][4][2], const Unit& u, int wr, int wc, int fr_, int fq_) const {
        int fr = fr_, fq = fq_; asm volatile("" : "+v"(fr), "+v"(fq));
        const int row0 = u.pm * BM + wr * 64 + fr, h = 2 * u.pn + (wc >> 1);
        float rs_own[2], skr_own[2];
#pragma unroll
        for (int ai = 0; ai < 2; ++ai) { rs_own[ai] = rstd_slots<4, 256>(SSQ_CKV, row0 + ai * HALF + fq * 16); skr_own[ai] = SKR[row0 + ai * HALF + fq * 16]; }
        if (wc & 1) {
#pragma unroll
            for (int ai = 0; ai < 2; ++ai)
#pragma unroll
                for (int m = 0; m < 4; ++m) { const int row = row0 + ai * HALF + m * 16; const float s = __shfl(rs_own[ai], fr + 16 * m); bf16_t* rowp = VB + (size_t)row * 512 + 64 * h + 8 * fq;
#pragma unroll
                    for (int bj = 0; bj < 2; ++bj) *(u32x4*)(rowp + 32 * bj) = pack8(acc[ai][bj][m][0] * s, acc[ai][bj][m][1] * s); }
        } else {
            f32x4 gk[2][2];
#pragma unroll
            for (int bj = 0; bj < 2; ++bj) { gk[bj][0] = *(const f32x4*)(g_kb + 32 * bj + 8 * fq); gk[bj][1] = *(const f32x4*)(g_kb + 32 * bj + 8 * fq + 4); }
#pragma unroll
            for (int ai = 0; ai < 2; ++ai) {
              f32x4 kr[4][2];
#pragma unroll
              for (int m = 0; m < 4; ++m) { const float* p = KR + (size_t)(row0 + ai * HALF + m * 16) * 32 + 8 * fq; kr[m][0] = *(const f32x4*)p; kr[m][1] = *(const f32x4*)(p + 4); }
              asm volatile("" ::: "memory");
#pragma unroll
                for (int m = 0; m < 4; ++m) { const int row = row0 + ai * HALF + m * 16; const float s = __shfl(rs_own[ai], fr + 16 * m), skr = __shfl(skr_own[ai], fr + 16 * m); float ss = 0.f;
#pragma unroll
                    for (int bj = 0; bj < 2; ++bj)
#pragma unroll
                        for (int n = 0; n < 2; ++n) { const f32x4 x = acc[ai][bj][m][n]; ss += (x[0] * x[0] + x[1] * x[1]) + (x[2] * x[2] + x[3] * x[3]); }
                    ss += __shfl_xor(ss, 16); ss += __shfl_xor(ss, 32);
                    const float rk = 1.0f / sqrtf((ss * s * s + skr) * (1.0f / 96.0f) + 1e-6f), sr = s * rk;
                    bf16_t* rowp = KBN + (size_t)row * 512 + 64 * h + 8 * fq;
#pragma unroll
                    for (int bj = 0; bj < 2; ++bj) *(u32x4*)(rowp + 32 * bj) = pack8(acc[ai][bj][m][0] * sr * gk[bj][0], acc[ai][bj][m][1] * sr * gk[bj][1]);
                    *(u32x4*)(KBR + (size_t)row * 256 + 32 * h + 8 * fq) = pack8(kr[m][0] * rk, kr[m][1] * rk); }
              asm volatile("" ::: "memory"); }
        }
    }
};
struct EpiF32ResB {
    static constexpr bool PERM = true, AFTER_DRAIN = false; static constexpr int RELAX_STORES = 0;
    const bf16_t* baseb; float* out; int ldc;
    __device__ __forceinline__ void operator()(const f32x4 (&acc)[2][2][4][2], const Unit& u, int wr, int wc, int fr_, int fq_) const {
        int fr = fr_, fq = fq_; asm volatile("" : "+v"(fr), "+v"(fq));
        const int row0 = u.pm * BM + wr * 64 + fr, col0 = u.pn * BM + wc * 32 + 8 * fq;
        u32x4 bb[2][4][2];
#pragma unroll
        for (int ai = 0; ai < 2; ++ai)
#pragma unroll
            for (int m = 0; m < 4; ++m)
#pragma unroll
                for (int bj = 0; bj < 2; ++bj) bb[ai][m][bj] = *(const u32x4*)(baseb + (size_t)(row0 + ai * HALF + m * 16) * ldc + col0 + bj * HALF);
        asm volatile("" ::: "memory");
#pragma unroll
        for (int ai = 0; ai < 2; ++ai)
#pragma unroll
            for (int m = 0; m < 4; ++m) { const size_t off = (size_t)(row0 + ai * HALF + m * 16) * ldc + col0;
#pragma unroll
                for (int bj = 0; bj < 2; ++bj) { const u32x4 b = bb[ai][m][bj];
                    f32x4 b0, b1; b0[0] = __uint_as_float(b.x << 16); b0[1] = __uint_as_float(b.x & 0xffff0000u); b0[2] = __uint_as_float(b.y << 16); b0[3] = __uint_as_float(b.y & 0xffff0000u);
                    b1[0] = __uint_as_float(b.z << 16); b1[1] = __uint_as_float(b.z & 0xffff0000u); b1[2] = __uint_as_float(b.w << 16); b1[3] = __uint_as_float(b.w & 0xffff0000u);
                    *(f32x4*)(out + off + bj * HALF) = b0 + acc[ai][bj][m][0]; *(f32x4*)(out + off + bj * HALF + 4) = b1 + acc[ai][bj][m][1]; } }
    }
};
struct EpiRelu2 {
    static constexpr bool PERM = true, AFTER_DRAIN = false; static constexpr int RELAX_STORES = 16;
    const float* ssq; bf16_t* O; int ldc;
    __device__ __forceinline__ void operator()(const f32x4 (&acc)[2][2][4][2], const Unit& u, int wr, int wc, int fr_, int fq_) const {
        int fr = fr_, fq = fq_; asm volatile("" : "+v"(fr), "+v"(fq));
        const int row0 = u.pm * BM + wr * 64 + fr, col0 = u.pn * BM + wc * 64 + 8 * fq;
        float rs[2][4]; rstd_rows8<16, 1024>(ssq, row0, fr, fq, rs);
#pragma unroll
        for (int ai = 0; ai < 2; ++ai)
#pragma unroll
            for (int m = 0; m < 4; ++m) { const int row = row0 + ai * HALF + m * 16; const float s = rs[ai][m]; bf16_t* rowp = O + (size_t)row * ldc + col0;
#pragma unroll
                for (int bj = 0; bj < 2; ++bj) { f32x4 v0 = acc[ai][bj][m][0] * s, v1 = acc[ai][bj][m][1] * s;
#pragma unroll
                    for (int i = 0; i < 4; ++i) { const float a = fmaxf(v0[i], 0.f), b = fmaxf(v1[i], 0.f); v0[i] = a * a; v1[i] = b * b; }
                    *(u32x4*)(rowp + bj * 32) = pack8(v0, v1); } }
    }
};
template <class Epi, class Sched, bool ALIGN_EPI = false, bool SP2 = false>
__device__ __forceinline__ void gemm_phase(PG8_LAS unsigned char* lds, const Gemm g, const Sched& S, const Epi& E) {
    int tid_ = threadIdx.x; asm volatile("" : "+v"(tid_));
    const int tid = tid_, wid = __builtin_amdgcn_readfirstlane(tid >> 6), lane = tid & 63, wr = wid >> 2, wc = wid & 3, fr = lane & 15, fq = lane >> 4;
    const int K = g.K, nt = K / BK;
    unsigned voffA[2], voffB[2];
#pragma unroll
    for (int i = 0; i < 2; ++i) { int R, C; stage_rc(tid * 16 + i * 8192, R, C); const int Rb = Epi::PERM ? ((R & ~31) + perm32(R & 31)) : R;
        voffA[i] = (unsigned)(R * K + C) * 2u; voffB[i] = (unsigned)(Rb * K + C) * 2u; }
    const size_t kstep = (size_t)(BK * 2);
    const size_t hstep = (size_t)HALF * K * 2;
    const size_t tstep = 2 * hstep;
    const unsigned ldsw = (unsigned)wid * 1024u;
    const int aoff = lds_byte(wr * 64 + fr, fq * 8), boff = lds_byte(wc * 32 + fr, fq * 8);
#define PG8_SA(b, h) (((b) * 2 + (h)) * HTB)
#define PG8_SB(b, h) ((4 + (b) * 2 + (h)) * HTB)
#define PG8_STAGE(bufoff, gbase, voff) do { _Pragma("unroll") for (int _i = 0; _i < 2; ++_i) \
        __builtin_amdgcn_global_load_lds((const unsigned*)((const char*)(gbase) + (voff)[_i]), (PG8_LAS unsigned*)(lds + (bufoff) + ldsw + _i * 8192), 16, 0, 0); } while (0)
#define PG8_LDA(dst, b, h) do { _Pragma("unroll") for (int m = 0; m < 4; ++m) _Pragma("unroll") for (int k = 0; k < 2; ++k) dst[m][k] = *(const PG8_LAS bf16x8*)(lds + PG8_SA(b, h) + aoff + m * 2048 + k * 1024); } while (0)
#define PG8_LDB(dst, b, h) do { _Pragma("unroll") for (int n = 0; n < 2; ++n) _Pragma("unroll") for (int k = 0; k < 2; ++k) dst[n][k] = *(const PG8_LAS bf16x8*)(lds + PG8_SB(b, h) + boff + n * 2048 + k * 1024); } while (0)
#define PG8_MMA(ai, bj, At, Bt) do { __builtin_amdgcn_s_setprio(1); _Pragma("unroll") for (int m = 0; m < 4; ++m) _Pragma("unroll") for (int n = 0; n < 2; ++n) _Pragma("unroll") for (int k = 0; k < 2; ++k) \
        acc[ai][bj][m][n] = __builtin_amdgcn_mfma_f32_16x16x32_bf16(Bt[n][k], At[m][k], acc[ai][bj][m][n], 0, 0, 0); __builtin_amdgcn_s_setprio(0); } while (0)
#define PG8_WAIT_V(n) asm volatile("s_waitcnt vmcnt(" #n ")" ::: "memory")
#define PG8_WAIT_V_RELAX(rx) asm volatile("s_cmp_lg_u32 %0, 0\n\ts_cbranch_scc1 1\n\ts_waitcnt vmcnt(8)\n\ts_waitcnt vmcnt(24)" :: "s"(rx) : "memory", "scc")
#define PG8_WAIT_L(n) asm volatile("s_waitcnt lgkmcnt(" #n ")" ::: "memory")
#define PG8_BAR __builtin_amdgcn_s_barrier()
#define PG8_SCHED __builtin_amdgcn_sched_barrier(0)
    Unit cur, nxt; int ui = 0;
    if (!S.next(0, cur)) return;
    f32x4 acc[2][2][4][2];
#pragma unroll
    for (int a = 0; a < 2; ++a)
#pragma unroll
        for (int b = 0; b < 2; ++b)
#pragma unroll
            for (int m = 0; m < 4; ++m)
#pragma unroll
                for (int n = 0; n < 2; ++n) acc[a][b][m][n] = (f32x4){0.f, 0.f, 0.f, 0.f};
    bf16x8 At[4][2], B0[2][2], B1[2][2];
    const char* cA = (const char*)g.A + (size_t)cur.pm * tstep; const char* cB = (const char*)g.Bt + (size_t)cur.pn * tstep;
    S.a_ready(cur);
    if constexpr (SP2) {
        PG8_STAGE(PG8_SB(0, 0), cB, voffB); PG8_STAGE(PG8_SB(0, 1), cB + hstep, voffB); PG8_STAGE(PG8_SA(0, 0), cA, voffA); PG8_STAGE(PG8_SA(0, 1), cA + hstep, voffA);
        if (wr == 1) PG8_BAR;
        PG8_WAIT_V(2); PG8_BAR;
        PG8_STAGE(PG8_SB(1, 0), cB + kstep, voffB); PG8_STAGE(PG8_SA(1, 0), cA + kstep, voffA); PG8_STAGE(PG8_SB(1, 1), cB + hstep + kstep, voffB);
        PG8_WAIT_V(6); PG8_BAR;
    } else {
        PG8_STAGE(PG8_SB(0, 0), cB, voffB); PG8_STAGE(PG8_SA(0, 0), cA, voffA); PG8_STAGE(PG8_SB(0, 1), cB + hstep, voffB); PG8_STAGE(PG8_SA(0, 1), cA + hstep, voffA);
        if (wr == 1) PG8_BAR;
        PG8_WAIT_V(4); PG8_BAR;
        PG8_STAGE(PG8_SB(1, 0), cB + kstep, voffB); PG8_STAGE(PG8_SA(1, 0), cA + kstep, voffA); PG8_STAGE(PG8_SB(1, 1), cB + hstep + kstep, voffB);
        PG8_WAIT_V(6); PG8_BAR;
    }
    for (;;) {
        const bool has_next = S.next(ui + 1, nxt);
        const char* nA = has_next ? (const char*)g.A + (size_t)nxt.pm * tstep : cA; const char* nB = has_next ? (const char*)g.Bt + (size_t)nxt.pn * tstep : cB;
        for (int t = 0; t < nt; t += 2) {
            const bool last = (t == nt - 2);
            const char* a1 = cA + (size_t)(t + 1) * kstep;
            const char* a2 = last ? nA : cA + (size_t)(t + 2) * kstep; const char* b2 = last ? nB : cB + (size_t)(t + 2) * kstep;
            const char* a3 = a2 + kstep; const char* b3 = b2 + kstep;
            if (last && has_next) S.a_ready(nxt);
            if constexpr (SP2) {
            PG8_LDB(B0, 0, 0); PG8_LDB(B1, 0, 1); PG8_SCHED; PG8_LDA(At, 0, 0); PG8_STAGE(PG8_SA(1, 1), a1 + hstep, voffA);
            if constexpr (Epi::RELAX_STORES >= 16) { const int rx = __builtin_amdgcn_readfirstlane((t == 0 && ui > 0) ? 1 : 0); PG8_WAIT_V_RELAX(rx); } else PG8_WAIT_V(8);
            PG8_WAIT_L(0); PG8_BAR; PG8_MMA(0, 0, At, B0); PG8_MMA(0, 1, At, B1); PG8_BAR; PG8_SCHED;
            PG8_LDA(At, 0, 1); PG8_STAGE(PG8_SB(0, 0), b2, voffB); PG8_STAGE(PG8_SB(0, 1), b2 + hstep, voffB); PG8_STAGE(PG8_SA(0, 0), a2, voffA);
            if constexpr (Epi::RELAX_STORES >= 16) { const int rx = __builtin_amdgcn_readfirstlane((t == 0 && ui > 0) ? 1 : 0); PG8_WAIT_V_RELAX(rx); } else PG8_WAIT_V(8);
            PG8_WAIT_L(0); PG8_BAR; PG8_MMA(1, 0, At, B0); PG8_MMA(1, 1, At, B1); PG8_BAR; PG8_SCHED;
            PG8_LDB(B0, 1, 0); PG8_LDB(B1, 1, 1); PG8_SCHED; PG8_LDA(At, 1, 0); PG8_STAGE(PG8_SA(0, 1), a2 + hstep, voffA);
            PG8_WAIT_V(8); PG8_WAIT_L(0); PG8_BAR; PG8_MMA(0, 0, At, B0); PG8_MMA(0, 1, At, B1); PG8_BAR; PG8_SCHED;
            PG8_LDA(At, 1, 1); PG8_STAGE(PG8_SB(1, 0), b3, voffB); PG8_STAGE(PG8_SB(1, 1), b3 + hstep, voffB); PG8_STAGE(PG8_SA(1, 0), a3, voffA);
            PG8_WAIT_V(8); PG8_WAIT_L(0); PG8_BAR; PG8_MMA(1, 0, At, B0); PG8_MMA(1, 1, At, B1); PG8_BAR; PG8_SCHED;
            } else {
            PG8_LDB(B0, 0, 0); PG8_SCHED; PG8_LDA(At, 0, 0); PG8_STAGE(PG8_SA(1, 1), a1 + hstep, voffA);
            PG8_WAIT_L(8); PG8_BAR; PG8_WAIT_L(0); PG8_MMA(0, 0, At, B0); PG8_BAR; PG8_SCHED;
            PG8_LDB(B1, 0, 1); PG8_STAGE(PG8_SB(0, 0), b2, voffB);
            PG8_BAR; PG8_WAIT_L(0); PG8_MMA(0, 1, At, B1); PG8_BAR;
            PG8_LDA(At, 0, 1); PG8_STAGE(PG8_SA(0, 0), a2, voffA);
            PG8_BAR; PG8_WAIT_L(0); PG8_MMA(1, 0, At, B0); PG8_BAR; PG8_SCHED;
            PG8_STAGE(PG8_SB(0, 1), b2 + hstep, voffB);
            PG8_WAIT_V(6); PG8_BAR; PG8_MMA(1, 1, At, B1); PG8_BAR;
            PG8_LDB(B0, 1, 0); PG8_SCHED; PG8_LDA(At, 1, 0); PG8_STAGE(PG8_SA(0, 1), a2 + hstep, voffA);
            PG8_WAIT_L(8); PG8_BAR; PG8_WAIT_L(0); PG8_MMA(0, 0, At, B0); PG8_BAR; PG8_SCHED;
            PG8_LDB(B1, 1, 1); PG8_STAGE(PG8_SB(1, 0), b3, voffB);
            PG8_BAR; PG8_WAIT_L(0); PG8_MMA(0, 1, At, B1); PG8_BAR;
            PG8_LDA(At, 1, 1); PG8_STAGE(PG8_SA(1, 0), a3, voffA);
            PG8_BAR; PG8_WAIT_L(0); PG8_MMA(1, 0, At, B0); PG8_BAR; PG8_SCHED;
            PG8_STAGE(PG8_SB(1, 1), b3 + hstep, voffB);
            PG8_WAIT_V(6); PG8_BAR; PG8_MMA(1, 1, At, B1); PG8_BAR;
            }
        }
        if constexpr (ALIGN_EPI) { if (wr == 0) PG8_BAR; }
        if constexpr (!Epi::AFTER_DRAIN) { E(acc, cur, wr, wc, fr, fq); S.done(cur); }
        if (!has_next) break;
#pragma unroll
        for (int a = 0; a < 2; ++a)
#pragma unroll
            for (int b = 0; b < 2; ++b)
#pragma unroll
                for (int m = 0; m < 4; ++m)
#pragma unroll
                    for (int n = 0; n < 2; ++n) acc[a][b][m][n] = (f32x4){0.f, 0.f, 0.f, 0.f};
        cur = nxt; cA = nA; cB = nB; ++ui;
        if constexpr (ALIGN_EPI) { if (wr == 1) PG8_BAR; }
    }
    PG8_WAIT_V(0);
    if constexpr (!ALIGN_EPI) { if (wr == 0) PG8_BAR; }
    PG8_BAR;
    if constexpr (Epi::AFTER_DRAIN) { E.fused(acc, cur, wr, wc, fr, fq, lds, wid, lane); S.done(cur); }
#undef PG8_SA
#undef PG8_SB
#undef PG8_STAGE
#undef PG8_LDA
#undef PG8_LDB
#undef PG8_MMA
#undef PG8_WAIT_V
#undef PG8_WAIT_L
#undef PG8_WAIT_V_RELAX
#undef PG8_BAR
#undef PG8_SCHED
}
}
#ifndef PG8_SP2
#define PG8_SP2 true
#endif
#ifndef PG8_ALIGN
#define PG8_ALIGN true
#endif
constexpr int NWAVES = 8;
#ifndef MK_N_LAUNCHES
#define MK_N_LAUNCHES 1
#endif
#define UKV_MAP 1
constexpr int BATCH = 4, SEQ = 4096, D = 1024, M = BATCH * SEQ, FF = 4096;
constexpr int HA = 8, DA = 64, WA = 512;
constexpr int HB = 8, DN = 64, DR = 32, DQK = 96, DV = 64;
constexpr int QLR = 768, KVLR = 256;
constexpr int NIN = 2592, NIN_PAD = 2816;
constexpr float EPS = 1e-6f;
constexpr float LOG2E = 1.4426950408889634f;
constexpr float QSCALE_A = 0.125f * LOG2E;
constexpr float QSCALE_B = 0.10206207261596575f * LOG2E;

constexpr size_t MiB = 1u << 20;
constexpr size_t WS_CTL = 0, CTL_ZERO_BYTES = 32 * 1024;
constexpr size_t WS_WIN = 1 * MiB;
constexpr size_t WS_WUQ = 7 * MiB;
constexpr size_t WS_WUKV = 8 * MiB + 512 * 1024;
constexpr size_t WS_WO = 9 * MiB;
constexpr size_t WS_W1 = 11 * MiB;
constexpr size_t WS_W2 = 19 * MiB;
constexpr size_t WS_CS = 27 * MiB;
constexpr size_t WS_KR = 29 * MiB;
constexpr size_t WS_SSQCQ = 31 * MiB;
constexpr size_t WS_SKR = 31 * MiB + 768 * 1024;
constexpr size_t WS_BIAS = 31 * MiB + 832 * 1024;
constexpr size_t WS_SSQCKV = 32 * MiB;
constexpr size_t WS_IRX = 32 * MiB + 512 * 1024;
constexpr size_t WS_SSQH = 27 * MiB;
constexpr size_t WS_ML = 33 * MiB;
constexpr size_t WS_XN = 36 * MiB;
constexpr size_t WS_H1B = 36 * MiB;
constexpr size_t WS_QA = 68 * MiB, WS_KA = 84 * MiB, WS_VA = 100 * MiB;
constexpr size_t WS_CQ = 116 * MiB;
constexpr size_t WS_CKV = 140 * MiB;
constexpr size_t WS_MIX = 116 * MiB;
constexpr size_t WS_QB = 148 * MiB;
constexpr size_t WS_KBN = 172 * MiB;
constexpr size_t WS_KBR = 188 * MiB;
constexpr size_t WS_VB = 196 * MiB;
constexpr size_t WS_HID = 128 * MiB;
constexpr size_t WS_END = 256 * MiB;

constexpr int CW_TMO = 0, CW_CODE = 1;
constexpr int CW_BAR = 4096;
constexpr int CW_AQ = 2048;
constexpr int RING_OFF = 0, RING_BYTES = 131072;
constexpr int LDSCTL_OFF = 139264, MISC_OFF = LDSCTL_OFF + 320;
constexpr int LDS_BYTES = 147456;
#define GAS __attribute__((address_space(1)))
#define LAS __attribute__((address_space(3)))
typedef unsigned short bf16;
typedef unsigned v4u __attribute__((ext_vector_type(4)));
typedef float f32x4 __attribute__((ext_vector_type(4)));
typedef short bf16x8 __attribute__((ext_vector_type(8)));
typedef GAS unsigned gu32;
typedef GAS unsigned long long gu64;
#define RLX_AGENT __ATOMIC_RELAXED, __HIP_MEMORY_SCOPE_AGENT
#define LDS_WAIT() asm volatile("s_waitcnt lgkmcnt(0)" ::: "memory")
#define VM_WAIT() asm volatile("s_waitcnt vmcnt(0)" ::: "memory")
__device__ __forceinline__ unsigned long long rt() { return __builtin_amdgcn_s_memrealtime(); }
__device__ __forceinline__ unsigned f2bf(float f) { unsigned u = __builtin_bit_cast(unsigned, f); return (u + 0x7fffu + ((u >> 16) & 1u)) >> 16; }
__device__ __forceinline__ unsigned pk2(float lo, float hi) { return f2bf(lo) | (f2bf(hi) << 16); }

#define XB_TMO      128
#define XB_XCNT(j)  (256  + 64 * (j))
#define XB_XSUB(j)  (1280 + 64 * (j))
#define XB_XGEN(j)  (2304 + 64 * (j))
#define XB_TOP      3328
#define XB_TOPGEN   3392
#define XCD_BAR_WORDS 3456
#define XB_SPIN_CAP (1u << 18)

__device__ __forceinline__ unsigned xb_ld(unsigned* p)              { return __hip_atomic_load(p, __ATOMIC_RELAXED, __HIP_MEMORY_SCOPE_AGENT); }
__device__ __forceinline__ unsigned xb_add(unsigned* p, unsigned v) { return __hip_atomic_fetch_add(p, v, __ATOMIC_RELAXED, __HIP_MEMORY_SCOPE_AGENT); }
__device__ __forceinline__ unsigned xb_xcc_id() { return (unsigned)__builtin_amdgcn_s_getreg((3 << 11) | 20) & 0xFu; }
#define XB_SPIN(cond, bar) do { unsigned _sp = 0; while (cond) { __builtin_amdgcn_s_sleep(1); \
    if ((++_sp & 255u) == 0u) { if (xb_ld(&(bar)[XB_TMO])) break; if (_sp > XB_SPIN_CAP) { atomicAdd(&(bar)[XB_TMO], 1u); break; } } } } while (0)

struct XcdBarrier {
    unsigned* bar; unsigned x;
    volatile LAS unsigned* st;
};

__device__ __forceinline__ XcdBarrier xcd_barrier_post(unsigned* bar, volatile LAS unsigned* st) {
    XcdBarrier b; b.bar = bar; b.x = xb_xcc_id(); b.st = st;
    if (threadIdx.x == 0) (void)xb_add(&bar[XB_XCNT(b.x)], 1u);
    return b;
}
__device__ __forceinline__ void xcd_barrier_complete(unsigned* bar, unsigned x, unsigned& nloc, unsigned& nx) {
    const unsigned G = gridDim.x * gridDim.y * gridDim.z;
    unsigned sum, cnt, mine, sp = 0u;
    for (;;) {
        sum = 0u; cnt = 0u; mine = 0u;
#pragma unroll
        for (unsigned j = 0; j < 16; ++j) { const unsigned c = xb_ld(&bar[XB_XCNT(j)]); sum += c; cnt += (c > 0u) ? 1u : 0u; mine = (j == x) ? c : mine; }
        if (sum == G) break;
        __builtin_amdgcn_s_sleep(1);
        if ((++sp & 255u) == 0u) { if (xb_ld(&bar[XB_TMO])) break; if (sp > XB_SPIN_CAP) { atomicAdd(&bar[XB_TMO], 1u); break; } }
    }
    nloc = mine > 0u ? mine : 1u; nx = cnt > 0u ? cnt : 1u;
}

__device__ __forceinline__ void xcd_barrier(const XcdBarrier& b) {
    asm volatile("s_waitcnt vmcnt(0)" ::: "memory");
    __syncthreads();
    if (threadIdx.x == 0) {
        unsigned* bar = b.bar;
        __builtin_amdgcn_s_waitcnt(0);
        unsigned nloc = b.st[0], nx = b.st[1];
        if (nloc == 0u) { xcd_barrier_complete(bar, b.x, nloc, nx); b.st[0] = nloc; b.st[1] = nx; }
        const unsigned old = xb_add(&bar[XB_XSUB(b.x)], 1u);
        const unsigned gen = old / nloc;
        if (old + 1u == (gen + 1u) * nloc) {
            __builtin_amdgcn_fence(__ATOMIC_RELEASE, "agent");
            asm volatile("s_waitcnt vmcnt(0)" ::: "memory");
            const unsigned og = xb_add(&bar[XB_TOP], 1u);
            const unsigned tg = og / nx;
            if (og + 1u == (tg + 1u) * nx) xb_add(&bar[XB_TOPGEN], 1u);
            else XB_SPIN(xb_ld(&bar[XB_TOPGEN]) == tg, bar);
            __builtin_amdgcn_fence(__ATOMIC_ACQUIRE, "agent");
            xb_add(&bar[XB_XGEN(b.x)], 1u);
            asm volatile("s_waitcnt vmcnt(0)" ::: "memory");
        } else {
            XB_SPIN(xb_ld(&bar[XB_XGEN(b.x)]) == gen, bar);
            __builtin_amdgcn_fence(__ATOMIC_ACQUIRE, "agent");
            asm volatile("s_waitcnt vmcnt(0)" ::: "memory");
        }
    }
    __syncthreads();
}
struct Frame {
    LAS unsigned char* lds;
    volatile LAS unsigned* MISC;
    gu32* ctl;
    int tid, lane, wave;
    int vcu, G;
};
__device__ __forceinline__ float wave_sum(float v) {
#pragma unroll
    for (int o = 1; o < 64; o <<= 1) v += __shfl_xor(v, o);
    return v;
}
__device__ __forceinline__ float bf2f(unsigned short u) { return __uint_as_float((unsigned)u << 16); }
__device__ __forceinline__ float bflo(unsigned w) { return __uint_as_float(w << 16); }
__device__ __forceinline__ float bfhi(unsigned w) { return __uint_as_float(w & 0xffff0000u); }

__device__ __forceinline__ int rowmap_sigma(int n) { if (n >= 2560) { const int d = n - 2560; return 2560 + (d < 16 ? d : 112 + d); } const int c = n & 255; return (n & ~255) + 128 * ((c >> 5) & 1) + 32 * (c >> 6) + (c & 31); }
template <int MAP> __device__ __forceinline__ void p0_transpose_item(const float* W, int K, int N, bf16* WT, const float* kscale, LAS float* scr, int item, int lane) {
    const int nblk = N / 32, kb = item / nblk, nb = item % nblk, k0 = 64 * kb, n0 = 32 * nb;
    f32x4 w[8]; const int rr = lane >> 3, c4 = (lane & 7) * 4;
#pragma unroll
    for (int i = 0; i < 8; ++i) w[i] = *(const GAS f32x4*)(W + (size_t)(k0 + 8 * i + rr) * N + n0 + c4);
#pragma unroll
    for (int i = 0; i < 8; ++i) { const int kk = 8 * i + rr; f32x4 v = w[i]; if (kscale) v = v * kscale[k0 + kk];
        scr[kk * 33 + c4] = v.x; scr[kk * 33 + c4 + 1] = v.y; scr[kk * 33 + c4 + 2] = v.z; scr[kk * 33 + c4 + 3] = v.w; }
    LDS_WAIT(); asm volatile("" ::: "memory");
    const int c = lane & 7;
#pragma unroll
    for (int j = 0; j < 4; ++j) { const int n = (lane >> 3) + 8 * j; const LAS float* s = scr + (8 * c) * 33 + n;
        v4u o; o.x = pk2(s[0 * 33], s[1 * 33]); o.y = pk2(s[2 * 33], s[3 * 33]); o.z = pk2(s[4 * 33], s[5 * 33]); o.w = pk2(s[6 * 33], s[7 * 33]);
        const int drow = MAP == 2 ? ((((n0 + n) & ~255) + 128 * (((n0 + n) >> 5) & 1) + 32 * (((n0 + n) & 255) >> 6) + ((n0 + n) & 31))) : (MAP ? rowmap_sigma(n0 + n) : (n0 + n)); *(GAS v4u*)(WT + (size_t)drow * K + k0 + 8 * c) = o; }
    LDS_WAIT(); asm volatile("" ::: "memory");
}
struct In { const float* x; const int* pos; const float *g_mix, *w_in, *g_qa, *g_ka, *rel_bias, *g_cq, *g_ckv, *w_uq, *w_ukv, *g_qb, *g_kb, *w_o, *g_ffn, *w1, *w2; };

__device__ __forceinline__ float inv_freq(int k) {
    const float t[16] = {1.000000000e+00f, 5.623413324e-01f, 3.162277639e-01f, 1.778279394e-01f, 1.000000015e-01f, 5.623413250e-02f, 3.162277490e-02f, 1.778279431e-02f,
                         9.999999776e-03f, 5.623413250e-03f, 3.162277630e-03f, 1.778279431e-03f, 1.000000047e-03f, 5.623413017e-04f, 3.162277571e-04f, 1.778279402e-04f};
    float r = t[0];
#pragma unroll
    for (int i = 1; i < 16; ++i) r = (k == i) ? t[i] : r;
    return r;
}
__device__ __forceinline__ int t5_bucket(int dist) {
    if (dist < 16) return dist;
    int l = 16 + (int)(logf((float)dist * (1.0f / 16.0f)) / 4.852030263919617f * 16.0f);
    return l < 31 ? l : 31;
}
constexpr int I_IN = (D / 64) * (NIN / 32), I_UQ = (QLR / 64) * (768 / 32), I_UKV = (KVLR / 64) * (1024 / 32), I_O = (D / 64) * (D / 32), I_1 = (D / 64) * (FF / 32), I_2 = (FF / 64) * (D / 32);
__device__ __forceinline__ void p0b_items(Frame& F, const In& I, unsigned char* ws, int gw, int NGW, int part) {
    LAS float* scr = (LAS float*)(F.lds + RING_OFF + F.wave * 16384);
    bf16* Wuq = (bf16*)(ws + WS_WUQ); bf16* Wukv = (bf16*)(ws + WS_WUKV); bf16* Wo = (bf16*)(ws + WS_WO); bf16* W1 = (bf16*)(ws + WS_W1); bf16* W2 = (bf16*)(ws + WS_W2);
    if (part == 1) { for (int it = gw; it < I_2; it += NGW) p0_transpose_item<0>(I.w2, FF, D, W2, nullptr, scr, it, F.lane); return; }
    constexpr int NITEMS = I_UQ + I_UKV + I_O + I_1;
    const int it_lo = (part == 4) ? NITEMS / 2 : 0, it_hi = (part == 3) ? NITEMS / 2 : NITEMS;
    for (int it = it_lo + gw; it < it_hi; it += NGW) {
        int r = it;
        if (r < I_UQ) { p0_transpose_item<0>(I.w_uq, QLR, 768, Wuq, I.g_cq, scr, r, F.lane); continue; } r -= I_UQ;
        if (r < I_UKV) { p0_transpose_item<UKV_MAP>(I.w_ukv, KVLR, 1024, Wukv, I.g_ckv, scr, r, F.lane); continue; } r -= I_UKV;
        if (r < I_O) { p0_transpose_item<0>(I.w_o, D, D, Wo, nullptr, scr, r, F.lane); continue; } r -= I_O;
        p0_transpose_item<2>(I.w1, D, FF, W1, I.g_ffn, scr, r, F.lane);
    }
}
__device__ __forceinline__ void p0_prologue(Frame& F, const In& I, unsigned char* ws) {
    LAS float* scr = (LAS float*)(F.lds + RING_OFF + F.wave * 16384);
    const int gw = F.vcu * NWAVES + F.wave, NGW = F.G * NWAVES;
    const int gt = gw * 64 + F.lane, NGT = NGW * 64;
    bf16* Win = (bf16*)(ws + WS_WIN);
    for (int it = gw; it < I_IN; it += NGW) p0_transpose_item<1>(I.w_in, D, NIN, Win, nullptr, scr, it, F.lane);
    { const int n16 = 112 * D * 2 / 16; GAS v4u* z0 = (GAS v4u*)(Win + (size_t)(2560 + 16) * D); GAS v4u* z1 = (GAS v4u*)(Win + (size_t)(2560 + 144) * D);
      for (int i = gt; i < n16; i += NGT) { z0[i] = (v4u){0u, 0u, 0u, 0u}; z1[i] = (v4u){0u, 0u, 0u, 0u}; } }
    bf16* XN = (bf16*)(ws + WS_XN);
    f32x4 g[4];
#pragma unroll
    for (int j = 0; j < 4; ++j) g[j] = *((const GAS f32x4*)I.g_mix + F.lane + 64 * j);
    for (int m0 = gw * 4; m0 < M; m0 += NGW * 4) {
        f32x4 v[4][4];
#pragma unroll
        for (int r = 0; r < 4; ++r)
#pragma unroll
            for (int j = 0; j < 4; ++j) v[r][j] = *((const GAS f32x4*)(I.x + (size_t)(m0 + r) * D) + F.lane + 64 * j);
#pragma unroll
        for (int r = 0; r < 4; ++r) { float s2 = 0.f;
#pragma unroll
            for (int j = 0; j < 4; ++j) s2 += (v[r][j].x * v[r][j].x + v[r][j].y * v[r][j].y) + (v[r][j].z * v[r][j].z + v[r][j].w * v[r][j].w);
            const float rstd = 1.f / sqrtf(wave_sum(s2) * (1.f / D) + EPS);
            GAS unsigned long long* o8 = (GAS unsigned long long*)(XN + (size_t)(m0 + r) * D) + F.lane;
#pragma unroll
            for (int j = 0; j < 4; ++j) o8[64 * j] = (unsigned long long)pk2(v[r][j].x * rstd * g[j].x, v[r][j].y * rstd * g[j].y) | ((unsigned long long)pk2(v[r][j].z * rstd * g[j].z, v[r][j].w * rstd * g[j].w) << 32); }
    }
    { float2* CS = (float2*)(ws + WS_CS);
      for (int i = gt; i < M * 16; i += NGT) { const int m = i >> 4, k = i & 15; const float ang = (float)I.pos[m] * inv_freq(k);
          const double a = (double)ang; const double n = __builtin_rint(a * 0.15915494309189535); const float r = (float)(a - n * 6.283185307179586);
          CS[i] = make_float2(__cosf(r), __sinf(r)); } }
    { float* BT = (float*)(ws + WS_BIAS);
      for (int i = gt; i < 3 * 8 * 132; i += NGT) { const int br = i / (8 * 132), h = (i / 132) % 8, j = i % 132; const int dil = br == 0 ? 1 : (br == 1 ? 4 : 16);
          BT[i] = j <= 128 ? I.rel_bias[t5_bucket(dil * j) * 8 + h] * LOG2E : 0.f; } }
}
namespace attb {
using bf16x8 = __attribute__((ext_vector_type(8))) short;
using s16x4 = __attribute__((ext_vector_type(4))) short;
using f32x16 = __attribute__((ext_vector_type(16))) float;
using u32x4 = __attribute__((ext_vector_type(4))) unsigned;
typedef short v4i16_t __attribute__((ext_vector_type(4)));
typedef __attribute__((address_space(3))) const char* lds_cptr;
typedef __attribute__((address_space(3))) char* lds_ptr;
constexpr int QB_ROWS = 256, KVBLK = 64, NQB = SEQ / QB_ROWS;
constexpr int KSLOT = 12288, VSLOT = 8192, NSLOT = 3;
constexpr int NVSLOT = 3, NKSLOT = 4;
constexpr int L_K = 0, L_V = NKSLOT * KSLOT, L_WS = L_V + NVSLOT * VSLOT, L_OST = L_WS + NWAVES * 256, L_BYTES = L_OST + NWAVES * 4096;
constexpr float THR = 6.0f;
constexpr float THR_B = 24.0f;
__device__ __forceinline__ int crow(int r, int hi) { return (r & 3) + 8 * (r >> 2) + 4 * hi; }
__device__ __forceinline__ void glds16(const void* gsrc, unsigned lds_dst) { unsigned keep;
    asm volatile("s_mov_b32 %0, m0\n\ts_mov_b32 m0, %2\n\ts_nop 0\n\tglobal_load_lds_dwordx4 %1, off\n\ts_mov_b32 m0, %0" : "=&s"(keep) : "v"(gsrc), "s"(lds_dst) : "memory"); }
typedef float f32x2_t __attribute__((ext_vector_type(2))); typedef __bf16 bf16x2_t __attribute__((ext_vector_type(2)));
__device__ __forceinline__ unsigned cvtpk(float lo, float hi) { f32x2_t v = {lo, hi}; bf16x2_t b = __builtin_convertvector(v, bf16x2_t); return __builtin_bit_cast(unsigned, b); }
__device__ __forceinline__ s16x4 vtr(lds_cptr p) { return __builtin_bit_cast(s16x4, __builtin_amdgcn_ds_read_tr16_b64_v4i16((__attribute__((address_space(3))) v4i16_t*)p)); }
__device__ __forceinline__ float max3f(float a, float b, float c) { float r; asm("v_max3_f32 %0, %1, %2, %3" : "=v"(r) : "v"(a), "v"(b), "v"(c)); return r; }
__device__ __forceinline__ float max2f(float a, float b) { float r; asm("v_max_f32_e32 %0, %1, %2" : "=v"(r) : "v"(a), "v"(b)); return r; }
__device__ __forceinline__ float fadd_s(float a, float b) { float r; asm("v_add_f32_e32 %0, %1, %2" : "=v"(r) : "v"(a), "v"(b)); return r; }
#define MX3(a, b, c) max3f((a), (b), (c))
__device__ __forceinline__ float rowmax32(const f32x16& p0, const f32x16& p1) {
    const float a0 = MX3(p0[0], p0[1], p0[2]), a1 = MX3(p0[3], p0[4], p0[5]), a2 = MX3(p0[6], p0[7], p0[8]), a3 = MX3(p0[9], p0[10], p0[11]), a4 = MX3(p0[12], p0[13], p0[14]);
    const float a5 = MX3(p1[0], p1[1], p1[2]), a6 = MX3(p1[3], p1[4], p1[5]), a7 = MX3(p1[6], p1[7], p1[8]), a8 = MX3(p1[9], p1[10], p1[11]), a9 = MX3(p1[12], p1[13], p1[14]);
    const float a10 = max2f(p0[15], p1[15]);
    const float b0 = MX3(a0, a1, a2), b1 = MX3(a3, a4, a5), b2 = MX3(a6, a7, a8), b3 = MX3(a9, a10, a10);
    const float m = max2f(MX3(b0, b1, b2), b3);
    auto rr = __builtin_amdgcn_permlane32_swap(__float_as_uint(m), __float_as_uint(m), false, false);
    return max2f(__uint_as_float(rr[0]), __uint_as_float(rr[1]));
}
__device__ __forceinline__ float rowsum32(const f32x16& p0, const f32x16& p1) {
    float t[16];
#pragma unroll
    for (int r = 0; r < 16; ++r) t[r] = fadd_s(p0[r], p1[r]);
#pragma unroll
    for (int r = 0; r < 8; ++r) t[r] = fadd_s(t[r], t[r + 8]);
#pragma unroll
    for (int r = 0; r < 4; ++r) t[r] = fadd_s(t[r], t[r + 4]);
    return fadd_s(fadd_s(t[0], t[2]), fadd_s(t[1], t[3]));
}
#define ATTB_WAIT_BAR(N) asm volatile("s_waitcnt vmcnt(" #N ") lgkmcnt(0)\n\ts_barrier" ::: "memory")
template <int VAR> __device__ __forceinline__ void unit(int b, int h, int qb, const bf16* Q, const bf16* KN, const bf16* KR, const bf16* V, bf16* O, lds_ptr shm, const float* g_qb, const float2* CS, const bf16* PO, const float2* ML, const bool fast) {
    int tid_ = threadIdx.x; asm volatile("" : "+v"(tid_));
    const int tid = tid_, lane = tid & 63, r32 = lane & 31, hi = lane >> 5; const int wid = __builtin_amdgcn_readfirstlane(tid >> 6);
    const long rowbase = (long)b * SEQ; const int q0 = qb * QB_ROWS;
    const unsigned lds0 = (unsigned)(uintptr_t)shm;
    __attribute__((address_space(3))) float* wsf = (__attribute__((address_space(3))) float*)(shm + L_WS) + wid * 64;
    const int krow = wid * 8 + (lane >> 3), rrow = (wid & 3) * 16 + (lane >> 2);
    const bf16* ksrc0 = KN + (rowbase + krow) * 512 + 64 * h + (((lane & 7) ^ ((krow >> 1) & 7)) * 8);
    const bf16* ksrc1 = KR + (rowbase + rrow) * 256 + 32 * h + (((lane & 3) ^ ((rrow >> 2) & 3)) * 8);
    const bf16* vsrc = V + (rowbase + 16 * (wid & 3) + (lane >> 2)) * 512 + 64 * h + (wid >> 2) * 32 + (lane & 3) * 8;
    const unsigned kdst0 = lds0 + L_K + wid * 1024, kdst1 = lds0 + L_K + 8192 + (wid & 3) * 1024, vdst = lds0 + L_V + wid * 1024;
#define ATTB_DMA_K(t, ks_) do { glds16(ksrc0 + (long)(t) * KVBLK * 512, (unsigned)__builtin_amdgcn_readfirstlane(kdst0 + (ks_) * KSLOT)); \
        if (wid < 4) glds16(ksrc1 + (long)(t) * KVBLK * 256, (unsigned)__builtin_amdgcn_readfirstlane(kdst1 + (ks_) * KSLOT)); } while (0)
#define ATTB_DMA_V(t, vs_) glds16(vsrc + (long)(t) * KVBLK * 512, (unsigned)__builtin_amdgcn_readfirstlane(vdst + (vs_) * VSLOT))
#define ATTB_DMA(t, ks_, vs_) do { ATTB_DMA_K(t, ks_); ATTB_DMA_V(t, vs_); } while (0)
    const int NT = (q0 + QB_ROWS) / KVBLK;
    ATTB_DMA(0, 0, 0); ATTB_DMA(1, 1, 1); if (fast) ATTB_DMA_K(2, 2);
    bf16x8 qr[6];
    { const long tok = rowbase + q0 + wid * 32 + r32; const bf16* Qw = Q + tok * 768 + 96 * h + hi * 8;
      float qv[6][8]; float ss = 0.f;
#pragma unroll
      for (int d0 = 0; d0 < 6; ++d0) { const u32x4 raw = *reinterpret_cast<const u32x4*>(Qw + d0 * 16);
          qv[d0][0] = bflo(raw.x); qv[d0][1] = bfhi(raw.x); qv[d0][2] = bflo(raw.y); qv[d0][3] = bfhi(raw.y); qv[d0][4] = bflo(raw.z); qv[d0][5] = bfhi(raw.z); qv[d0][6] = bflo(raw.w); qv[d0][7] = bfhi(raw.w);
#pragma unroll
          for (int j = 0; j < 8; ++j) ss += qv[d0][j] * qv[d0][j]; }
      ss += __shfl_xor(ss, 32);
      const float rstd = 1.0f / sqrtf(ss * (1.0f / 96.0f) + EPS);
#pragma unroll
      for (int d0 = 0; d0 < 6; ++d0) { const f32x4 g0 = *(const f32x4*)(g_qb + 16 * d0 + 8 * hi), g1 = *(const f32x4*)(g_qb + 16 * d0 + 8 * hi + 4);
#pragma unroll
          for (int j = 0; j < 4; ++j) { qv[d0][j] *= rstd * g0[j]; qv[d0][4 + j] *= rstd * g1[j]; } }
#pragma unroll
      for (int j = 0; j < 8; ++j) { const float2 cs = CS[tok * 16 + 8 * hi + j]; const float x1 = qv[4][j], x2 = qv[5][j]; qv[4][j] = x1 * cs.x - x2 * cs.y; qv[5][j] = x2 * cs.x + x1 * cs.y; }
#pragma unroll
      for (int d0 = 0; d0 < 6; ++d0) { const u32x4 w = (u32x4){cvtpk(qv[d0][0] * QSCALE_B, qv[d0][1] * QSCALE_B), cvtpk(qv[d0][2] * QSCALE_B, qv[d0][3] * QSCALE_B), cvtpk(qv[d0][4] * QSCALE_B, qv[d0][5] * QSCALE_B), cvtpk(qv[d0][6] * QSCALE_B, qv[d0][7] * QSCALE_B)};
          qr[d0] = __builtin_bit_cast(bf16x8, w); } }
    float mhat = 0.f, l_run = 0.f; f32x16 o[2]; o[0] = f32x16{}; o[1] = f32x16{};
    const int qrel = wid * 32 + r32;
    const lds_cptr kp0 = (lds_cptr)shm + L_K + r32 * 128, kr0 = (lds_cptr)shm + L_K + 8192 + r32 * 64;
    int koff[6];
#pragma unroll
    for (int d0 = 0; d0 < 4; ++d0) koff[d0] = ((2 * d0 + hi) ^ ((r32 >> 1) & 7)) * 16;
#pragma unroll
    for (int d0 = 4; d0 < 6; ++d0) koff[d0] = ((2 * (d0 - 4) + hi) ^ ((r32 >> 2) & 3)) * 16;
    const lds_cptr vp0 = (lds_cptr)shm + L_V + ((lane >> 4) & 1) * 32 + (lane & 3) * 8 + (4 * hi + ((lane & 15) >> 2)) * 64;
    f32x16 p0, p1; const f32x16 zero16 = f32x16{};
#define ATTB_SKIP(tt) (((tt) - (NT - 4)) >= 1 && wid < 2 * ((tt) - (NT - 4)))
#define ATTB_QK(tt, sl) do { if (!ATTB_SKIP(tt)) { const lds_cptr kp = kp0 + (sl) * KSLOT, kr = kr0 + (sl) * KSLOT; \
        bf16x8 kf[12];     \
        _Pragma("unroll") for (int d0 = 0; d0 < 6; ++d0) { const lds_cptr ka = (d0 < 4 ? kp : kr) + koff[d0]; \
            kf[2 * d0] = *(const __attribute__((address_space(3))) bf16x8*)(ka); kf[2 * d0 + 1] = *(const __attribute__((address_space(3))) bf16x8*)(ka + (d0 < 4 ? 4096 : 2048)); } \
        __builtin_amdgcn_sched_barrier(0); \
        p0 = __builtin_amdgcn_mfma_f32_32x32x16_bf16(kf[0], qr[0], zero16, 0, 0, 0); p1 = __builtin_amdgcn_mfma_f32_32x32x16_bf16(kf[1], qr[0], zero16, 0, 0, 0); \
        _Pragma("unroll") for (int d0 = 1; d0 < 6; ++d0) { p0 = __builtin_amdgcn_mfma_f32_32x32x16_bf16(kf[2 * d0], qr[d0], p0, 0, 0, 0); p1 = __builtin_amdgcn_mfma_f32_32x32x16_bf16(kf[2 * d0 + 1], qr[d0], p1, 0, 0, 0); } \
        __builtin_amdgcn_sched_barrier(0); \
        const int jb_ = (tt) - (NT - 4); \
        if (jb_ >= 0) { const int kb = 64 * jb_ + 4 * hi; \
            _Pragma("unroll") for (int r = 0; r < 16; ++r) { const int kv = kb + (r & 3) + 8 * (r >> 2); if (kv > qrel) p0[r] = -INFINITY; if (kv + 32 > qrel) p1[r] = -INFINITY; } } } } while (0)
#define ATTB_SMPV(tt, sl) do { if (!ATTB_SKIP(tt)) { const lds_cptr vp = vp0 + (sl) * VSLOT; \
        float rm = rowmax32(p0, p1);        \
        if (__any(rm - mhat > THR_B)) { \
            const float dl = fmaxf(rm - mhat, 0.f), f = __builtin_amdgcn_exp2f(-dl); \
            mhat += dl; l_run *= f; \
            if (hi == 0) wsf[r32] = f; \
            asm volatile("s_waitcnt lgkmcnt(0)" ::: "memory"); \
            _Pragma("unroll") for (int r = 0; r < 16; ++r) { const float fr = wsf[crow(r, hi)]; o[0][r] *= fr; o[1][r] *= fr; } \
        } \
        if (__any(mhat != 0.f)) { _Pragma("unroll") for (int r = 0; r < 16; ++r) { p0[r] -= mhat; p1[r] -= mhat; } } \
        _Pragma("unroll") for (int r = 0; r < 16; ++r) { p0[r] = __builtin_amdgcn_exp2f(p0[r]); p1[r] = __builtin_amdgcn_exp2f(p1[r]); } \
        l_run += rowsum32(p0, p1); \
        u32x4 pw[4]; \
        _Pragma("unroll") for (int k = 0; k < 2; ++k) { pw[k] = (u32x4){cvtpk(p0[8 * k], p0[8 * k + 1]), cvtpk(p0[8 * k + 2], p0[8 * k + 3]), cvtpk(p0[8 * k + 4], p0[8 * k + 5]), cvtpk(p0[8 * k + 6], p0[8 * k + 7])}; \
            pw[2 + k] = (u32x4){cvtpk(p1[8 * k], p1[8 * k + 1]), cvtpk(p1[8 * k + 2], p1[8 * k + 3]), cvtpk(p1[8 * k + 4], p1[8 * k + 5]), cvtpk(p1[8 * k + 6], p1[8 * k + 7])}; } \
        s16x4 vl[8], vh[8];     \
        _Pragma("unroll") for (int i = 0; i < 8; ++i) { vl[i] = vtr(vp + (i >> 2) * 4096 + (i & 3) * 1024); vh[i] = vtr(vp + (i >> 2) * 4096 + (i & 3) * 1024 + 512); } \
        __builtin_amdgcn_sched_barrier(0); \
        _Pragma("unroll") for (int ks = 0; ks < 4; ++ks) \
            _Pragma("unroll") for (int d0 = 0; d0 < 2; ++d0) { const int i = 4 * d0 + ks; \
                const bf16x8 vf = (bf16x8){vl[i][0], vl[i][1], vl[i][2], vl[i][3], vh[i][0], vh[i][1], vh[i][2], vh[i][3]}; \
                o[d0] = __builtin_amdgcn_mfma_f32_32x32x16_bf16(__builtin_bit_cast(bf16x8, pw[ks]), vf, o[d0], 0, 0, 0); } \
        __builtin_amdgcn_sched_barrier(0); } } while (0)
    if (!fast) {
    for (int i = 0; i < NT; ++i) {
        if (i + 1 < NT) { if (wid < 4) ATTB_WAIT_BAR(3); else ATTB_WAIT_BAR(2); } else ATTB_WAIT_BAR(0);
        if (i + 2 < NT) ATTB_DMA(i + 2, (i + 2) % 3, (i + 2) % 3);
        ATTB_QK(i, i % 3);
        ATTB_SMPV(i, i % 3);
    }
    } else {
#define ATTB_FQK(PN0, PN1, tt) do { const lds_cptr kp = kp0 + ((tt) & 3) * KSLOT, kr = kr0 + ((tt) & 3) * KSLOT; \
        bf16x8 ka_[6], kb_[6]; \
        _Pragma("unroll") for (int d0 = 0; d0 < 3; ++d0) { ka_[2 * d0] = *(const __attribute__((address_space(3))) bf16x8*)(kp + koff[d0]); ka_[2 * d0 + 1] = *(const __attribute__((address_space(3))) bf16x8*)(kp + koff[d0] + 4096); } \
        kb_[0] = *(const __attribute__((address_space(3))) bf16x8*)(kp + koff[3]); kb_[1] = *(const __attribute__((address_space(3))) bf16x8*)(kp + koff[3] + 4096); \
        _Pragma("unroll") for (int d0 = 4; d0 < 6; ++d0) { kb_[2 * (d0 - 3)] = *(const __attribute__((address_space(3))) bf16x8*)(kr + koff[d0]); kb_[2 * (d0 - 3) + 1] = *(const __attribute__((address_space(3))) bf16x8*)(kr + koff[d0] + 2048); } \
        PN0 = __builtin_amdgcn_mfma_f32_32x32x16_bf16(ka_[0], qr[0], zero16, 0, 0, 0); PN1 = __builtin_amdgcn_mfma_f32_32x32x16_bf16(ka_[1], qr[0], zero16, 0, 0, 0); \
        _Pragma("unroll") for (int d0 = 1; d0 < 3; ++d0) { PN0 = __builtin_amdgcn_mfma_f32_32x32x16_bf16(ka_[2 * d0], qr[d0], PN0, 0, 0, 0); PN1 = __builtin_amdgcn_mfma_f32_32x32x16_bf16(ka_[2 * d0 + 1], qr[d0], PN1, 0, 0, 0); } \
        _Pragma("unroll") for (int d0 = 3; d0 < 6; ++d0) { PN0 = __builtin_amdgcn_mfma_f32_32x32x16_bf16(kb_[2 * (d0 - 3)], qr[d0], PN0, 0, 0, 0); PN1 = __builtin_amdgcn_mfma_f32_32x32x16_bf16(kb_[2 * (d0 - 3) + 1], qr[d0], PN1, 0, 0, 0); } } while (0)
#define ATTB_FMASK(PN0, PN1, tt) do { const int jb_ = (tt) - (NT - 4); \
        if (jb_ >= 0) { const int kb = 64 * jb_ + 4 * hi; \
            _Pragma("unroll") for (int r = 0; r < 16; ++r) { const int kv = kb + (r & 3) + 8 * (r >> 2); if (kv > qrel) PN0[r] = -INFINITY; if (kv + 32 > qrel) PN1[r] = -INFINITY; } } } while (0)
#define ATTB_FEXP(P0_, P1_) do { _Pragma("unroll") for (int r = 0; r < 16; ++r) { P0_[r] = __builtin_amdgcn_exp2f(P0_[r]); P1_[r] = __builtin_amdgcn_exp2f(P1_[r]); } } while (0)
#define ATTB_FSUMPACK(PC0, PC1) do { l_run += rowsum32(PC0, PC1); \
        _Pragma("unroll") for (int k = 0; k < 2; ++k) { pw[k] = (u32x4){cvtpk(PC0[8 * k], PC0[8 * k + 1]), cvtpk(PC0[8 * k + 2], PC0[8 * k + 3]), cvtpk(PC0[8 * k + 4], PC0[8 * k + 5]), cvtpk(PC0[8 * k + 6], PC0[8 * k + 7])}; \
            pw[2 + k] = (u32x4){cvtpk(PC1[8 * k], PC1[8 * k + 1]), cvtpk(PC1[8 * k + 2], PC1[8 * k + 3]), cvtpk(PC1[8 * k + 4], PC1[8 * k + 5]), cvtpk(PC1[8 * k + 6], PC1[8 * k + 7])}; } } while (0)
#define ATTB_FPV(tt) do { const lds_cptr vp = (lds_cptr)(uintptr_t)(((unsigned)(uintptr_t)(vp0 + ((tt) % 3) * VSLOT)) & 0x3ffffu);     \
        _Pragma("unroll") for (int ks = 0; ks < 4; ++ks) \
            _Pragma("unroll") for (int d0 = 0; d0 < 2; ++d0) { \
                const s16x4 lo = vtr(vp + d0 * 4096 + ks * 1024), hh = vtr(vp + d0 * 4096 + ks * 1024 + 512); \
                const bf16x8 vf = (bf16x8){lo[0], lo[1], lo[2], lo[3], hh[0], hh[1], hh[2], hh[3]}; \
                o[d0] = __builtin_amdgcn_mfma_f32_32x32x16_bf16(__builtin_bit_cast(bf16x8, pw[ks]), vf, o[d0], 0, 0, 0); } } while (0)
        f32x16 pn0, pn1, pc0, pc1; u32x4 pw[4];
        ATTB_WAIT_BAR(0);
        ATTB_FQK(pn0, pn1, 0); ATTB_FMASK(pn0, pn1, 0); ATTB_FEXP(pn0, pn1);
        int t = 0;
        for (; t + 6 <= NT; ++t) {
            if (t > 0) { if (wid < 4) ATTB_WAIT_BAR(3); else ATTB_WAIT_BAR(2); }
            ATTB_DMA_K(t + 3, (t + 3) & 3); ATTB_DMA_V(t + 2, (t + 2) % 3);
            pc0 = pn0; pc1 = pn1;
            ATTB_FQK(pn0, pn1, t + 1);
            ATTB_FSUMPACK(pc0, pc1);
            ATTB_FPV(t);
            ATTB_FEXP(pn0, pn1);
        }
        for (; t < NT; ++t) {
            if (t > 0) ATTB_WAIT_BAR(0);
            if (t + 3 < NT) ATTB_DMA_K(t + 3, (t + 3) & 3);
            if (t + 2 < NT) ATTB_DMA_V(t + 2, (t + 2) % 3);
            pc0 = pn0; pc1 = pn1;
            if (t + 1 < NT && !ATTB_SKIP(t + 1)) { ATTB_FQK(pn0, pn1, t + 1); ATTB_FMASK(pn0, pn1, t + 1); ATTB_FEXP(pn0, pn1); }
            if (!ATTB_SKIP(t)) { ATTB_FSUMPACK(pc0, pc1); ATTB_FPV(t); }
        }
#undef ATTB_FEXP
#undef ATTB_FSUMPACK
#undef ATTB_FPV
#undef ATTB_FQK
#undef ATTB_FMASK
    }
#undef ATTB_QK
#undef ATTB_SMPV
#undef ATTB_SKIP
    { auto rr = __builtin_amdgcn_permlane32_swap(__float_as_uint(l_run), __float_as_uint(l_run), false, false); l_run = __uint_as_float(rr[0]) + __uint_as_float(rr[1]); }
    if (hi == 0) wsf[32 + r32] = l_run;
    asm volatile("s_waitcnt lgkmcnt(0)" ::: "memory");
    float rli[16];
#pragma unroll
    for (int r = 0; r < 16; ++r) rli[r] = 1.0f / wsf[32 + crow(r, hi)];
    bf16* Ow = O + (rowbase + q0 + wid * 32) * 1024 + 512 + 64 * h;
    { __attribute__((address_space(3))) bf16* stg = (__attribute__((address_space(3))) bf16*)(shm + L_OST) + wid * 2048;
#pragma unroll
      for (int r = 0; r < 16; ++r) { const int orow = crow(r, hi);
#pragma unroll
          for (int d0 = 0; d0 < 2; ++d0) stg[orow * 64 + d0 * 32 + r32] = (bf16)f2bf(o[d0][r] * rli[r]); }
      asm volatile("s_waitcnt lgkmcnt(0)" ::: "memory");
#pragma unroll
      for (int i = 0; i < 4; ++i) { const int row = i * 8 + (lane >> 3), ch = lane & 7; const u32x4 v = *(const __attribute__((address_space(3))) u32x4*)(stg + row * 64 + ch * 8); *(u32x4*)(Ow + (long)row * 1024 + ch * 8) = v; } }
    { constexpr size_t PO_STRIDE = (size_t)M * 512;
      float2 mla[4][3]; u32x4 xs[4][3];
#pragma unroll
      for (int i = 0; i < 4; ++i) { const int row = i * 8 + (lane >> 3), ch = lane & 7; const size_t m = (size_t)(rowbase + q0 + wid * 32 + row);
#pragma unroll
          for (int br = 0; br < 3; ++br) { mla[i][br] = ML[((size_t)br * M + m) * 8 + h]; xs[i][br] = *(const u32x4*)(PO + br * PO_STRIDE + m * 512 + 64 * h + ch * 8); } }
      asm volatile("" ::: "memory");
#pragma unroll
      for (int i = 0; i < 4; ++i) { const int row = i * 8 + (lane >> 3), ch = lane & 7; const size_t m = (size_t)(rowbase + q0 + wid * 32 + row);
          const float2 a = mla[i][0], bq = mla[i][1], cq = mla[i][2];
          const float mx = fmaxf(fmaxf(a.x, bq.x), cq.x);
          float w0 = a.y * __builtin_amdgcn_exp2f(a.x - mx), w1 = bq.y * __builtin_amdgcn_exp2f(bq.x - mx), w2 = cq.y * __builtin_amdgcn_exp2f(cq.x - mx);
          const float inv = 1.0f / (w0 + w1 + w2); w0 *= inv; w1 *= inv; w2 *= inv;
          const u32x4 x0 = xs[i][0], x1 = xs[i][1], x2 = xs[i][2];
          u32x4 ov;
          ov.x = cvtpk(w0 * bflo(x0.x) + w1 * bflo(x1.x) + w2 * bflo(x2.x), w0 * bfhi(x0.x) + w1 * bfhi(x1.x) + w2 * bfhi(x2.x));
          ov.y = cvtpk(w0 * bflo(x0.y) + w1 * bflo(x1.y) + w2 * bflo(x2.y), w0 * bfhi(x0.y) + w1 * bfhi(x1.y) + w2 * bfhi(x2.y));
          ov.z = cvtpk(w0 * bflo(x0.z) + w1 * bflo(x1.z) + w2 * bflo(x2.z), w0 * bfhi(x0.z) + w1 * bfhi(x1.z) + w2 * bfhi(x2.z));
          ov.w = cvtpk(w0 * bflo(x0.w) + w1 * bflo(x1.w) + w2 * bflo(x2.w), w0 * bfhi(x0.w) + w1 * bfhi(x1.w) + w2 * bfhi(x2.w));
          *(u32x4*)(O + m * 1024 + 64 * h + ch * 8) = ov; } }
    asm volatile("s_waitcnt vmcnt(0) lgkmcnt(0)\n\ts_barrier" ::: "memory");
#undef ATTB_DMA
#undef ATTB_DMA_K
#undef ATTB_DMA_V
}
__device__ __forceinline__ bool score_bound_ok(const float* g_qb, const float* g_kb) {
    int l_ = threadIdx.x; asm volatile("" : "+v"(l_)); const int l = l_ & 63;
    float gq = fmaxf(fabsf(g_qb[l]), fabsf(g_qb[32 + (l & 31)])); gq = fmaxf(gq, fabsf(g_qb[64 + (l & 31)])); float gk = fmaxf(fabsf(g_kb[l]), fabsf(g_kb[64 + (l & 31)]));
#pragma unroll
    for (int o_ = 1; o_ < 64; o_ <<= 1) { gq = fmaxf(gq, __shfl_xor(gq, o_)); gk = fmaxf(gk, __shfl_xor(gk, o_)); }
    return __builtin_amdgcn_readfirstlane((int)(96.0f * QSCALE_B * gq * gk < 60.0f)) != 0; }
template <int VAR> __device__ __forceinline__ void phase(unsigned char* lds, int vcu, int G, const bf16* Q, const bf16* KN, const bf16* KR, const bf16* V, bf16* O, const float* g_qb, const float2* CS, const bf16* PO, const float2* ML, const bool fast) {
    for (int v = vcu; v < BATCH * HB * 8; v += G) {
        const int bh = v >> 3, s = v & 7;
        unit<VAR>(bh / HB, bh % HB, 15 - s, Q, KN, KR, V, O, (lds_ptr)lds, g_qb, CS, PO, ML, fast);
        unit<VAR>(bh / HB, bh % HB, s, Q, KN, KR, V, O, (lds_ptr)lds, g_qb, CS, PO, ML, fast);
    }
}
#undef ATTB_WAIT_BAR
}
namespace atta {
using namespace attb;
constexpr int BCOPY = 272;
constexpr int L_K = 0, L_V = 6 * 8192, L_BIAS = 12 * 8192, L_ID = L_BIAS + 4 * BCOPY * 4, L_WS = L_ID + 256, L_OST = L_WS + NWAVES * 256, L_BYTES = L_OST + NWAVES * 4096;
constexpr size_t PO_STRIDE = (size_t)M * 512;
constexpr float THR_A = 20.0f;
struct UnitA { int b, h, br, rho, c, dil; long tok0; };
__device__ __forceinline__ UnitA decode(int id) { UnitA u; const int bh = id / 48, r = id % 48, k = r & 15; u.br = r >> 4; u.b = bh >> 3; u.h = bh & 7;
    u.rho = u.br == 0 ? 0 : (u.br == 1 ? (k >> 2) : k); u.c = u.br == 0 ? k : (u.br == 1 ? (k & 3) : 0); u.dil = u.br == 0 ? 1 : (u.br == 1 ? 4 : 16); u.tok0 = (long)u.b * SEQ + u.rho; return u; }
constexpr int NUNITS = 32 * 48;
__device__ __forceinline__ bool score_bound_ok(const float* g_qa, const float* g_ka, const float* RB) {
    int l_ = threadIdx.x; asm volatile("" : "+v"(l_)); const int lane = l_ & 63;
    float gq = fabsf(g_qa[lane]), gk = fabsf(g_ka[lane]), bm = 0.f;
    for (int i = lane; i < 32 * 8; i += 64) bm = fmaxf(bm, fabsf(RB[i]) * LOG2E);
#pragma unroll
    for (int o_ = 1; o_ < 64; o_ <<= 1) { gq = fmaxf(gq, __shfl_xor(gq, o_)); gk = fmaxf(gk, __shfl_xor(gk, o_)); bm = fmaxf(bm, __shfl_xor(bm, o_)); }
    return __builtin_amdgcn_readfirstlane((int)(64.0f * QSCALE_A * gq * gk + bm < 60.0f)) != 0; }
template <int VAR> __device__ __forceinline__ void phase(unsigned char* lds, unsigned* counter, const bf16* Q, const bf16* K, const bf16* V, const float* BT, bf16* PO, float2* ML, const bool fast) {
    lds_ptr shm = (lds_ptr)lds;
    int tid_ = threadIdx.x; asm volatile("" : "+v"(tid_));
    const int tid = tid_, lane = tid & 63, r32 = lane & 31, hi = lane >> 5; const int wid = __builtin_amdgcn_readfirstlane(tid >> 6);
    const unsigned lds0 = (unsigned)(uintptr_t)shm;
    __attribute__((address_space(3))) float* wsf = (__attribute__((address_space(3))) float*)(shm + L_WS) + wid * 64;
    __attribute__((address_space(3))) float* bias = (__attribute__((address_space(3))) float*)(shm + L_BIAS);
    volatile __attribute__((address_space(3))) int* idw = (volatile __attribute__((address_space(3))) int*)(shm + L_ID);
    const lds_cptr kp0 = (lds_cptr)shm + L_K + r32 * 128;
    int koff[4];
#pragma unroll
    for (int d0 = 0; d0 < 4; ++d0) koff[d0] = ((2 * d0 + hi) ^ ((r32 >> 1) & 7)) * 16;
    const lds_cptr vp0 = (lds_cptr)shm + L_V + ((lane >> 4) & 1) * 32 + (lane & 3) * 8 + (4 * hi + ((lane & 15) >> 2)) * 64;
    bf16x8 qr[4];
    bf16x8 qn[4]; float bn[2];
#define ATTA_LOADS(u) do { \
        _Pragma("unroll") for (int e_ = 0; e_ < 2; ++e_) { const int ent_ = tid + 512 * e_, y_ = 255 - ((ent_ & 255) + (ent_ >> 8)) - 64; bn[e_] = (y_ >= 0 && y_ <= 128) ? BT[((u).br * 8 + (u).h) * 132 + y_] : -INFINITY; } \
        { const long qt_ = (u).tok0 + (long)(u).dil * (256 * (u).c + wid * 32 + r32); \
          _Pragma("unroll") for (int d0 = 0; d0 < 4; ++d0) qn[d0] = *reinterpret_cast<const bf16x8*>(Q + qt_ * 512 + 64 * (u).h + d0 * 16 + hi * 8); } } while (0)
#define ATTA_ISSUE(u) do { asm volatile("" : "+v"(qn[0]), "+v"(qn[1]), "+v"(qn[2]), "+v"(qn[3]), "+v"(bn[0]), "+v"(bn[1]));     \
        bias[(tid >> 8) * BCOPY + (tid & 255)] = bn[0]; bias[((tid >> 8) + 2) * BCOPY + (tid & 255)] = bn[1]; \
        _Pragma("unroll") for (int d0 = 0; d0 < 4; ++d0) qr[d0] = qn[d0]; \
        asm volatile("" ::: "memory"); \
        const int tmin_ = ((u).c == 0) ? 2 : 0; const int u0_ = 256 * (u).c - 128; \
        for (int tau = tmin_; tau < 6; ++tau) { const int uk = u0_ + 64 * tau; \
            glds16(K + ((u).tok0 + (long)(u).dil * (uk + wid * 8 + (lane >> 3))) * 512 + 64 * (u).h + (((lane & 7) ^ (((wid * 8 + (lane >> 3)) >> 1) & 7)) * 8), (unsigned)__builtin_amdgcn_readfirstlane(lds0 + L_K + tau * 8192 + wid * 1024)); \
            glds16(V + ((u).tok0 + (long)(u).dil * (uk + 16 * (wid & 3) + (lane >> 2))) * 512 + 64 * (u).h + (wid >> 2) * 32 + (lane & 3) * 8, (unsigned)__builtin_amdgcn_readfirstlane(lds0 + L_V + tau * 8192 + wid * 1024)); } } while (0)
    if (tid == 0) idw[0] = (int)__hip_atomic_fetch_add(counter, 1u, __ATOMIC_RELAXED, __HIP_MEMORY_SCOPE_AGENT);
    asm volatile("s_waitcnt vmcnt(0) lgkmcnt(0)\n\ts_barrier" ::: "memory");
    int id = __builtin_amdgcn_readfirstlane(idw[0]), par = 0;
    if (id >= NUNITS) return;
    UnitA u = decode(id);
    ATTA_LOADS(u); ATTA_ISSUE(u);
    for (;;) {
        if (tid == 0) idw[par ^ 1] = (int)__hip_atomic_fetch_add(counter, 1u, __ATOMIC_RELAXED, __HIP_MEMORY_SCOPE_AGENT);
        float mhat = 0.f, l_run = 0.f; f32x16 o[2]; o[0] = f32x16{}; o[1] = f32x16{}; f32x16 negm = f32x16{}; asm volatile("" : "+v"(negm));
        const int tau_min = (u.c == 0) ? 2 : 0;
        asm volatile("s_waitcnt vmcnt(0) lgkmcnt(0)\n\ts_barrier" ::: "memory");
        const int nid = __builtin_amdgcn_readfirstlane(idw[par ^ 1]); par ^= 1;
        const bool more = nid < NUNITS;
        UnitA nu = u; if (more) { nu = decode(nid); ATTA_LOADS(nu); }
        const __attribute__((address_space(3))) f32x4* biasv;
        { const int A0 = 63 - 32 * (wid & 1) - r32 + 4 * hi; biasv = (const __attribute__((address_space(3))) f32x4*)(bias + BCOPY * (A0 & 3) + (A0 & ~3)); }
        if (fast && (wid >> 1) >= tau_min) {
#define ATTA_FQK(PN0, PN1, ii) do { const lds_cptr kp = kp0 + ((wid >> 1) + (ii)) * 8192; \
            bf16x8 kf[8]; \
            _Pragma("unroll") for (int d0 = 0; d0 < 4; ++d0) { kf[2 * d0] = *(const __attribute__((address_space(3))) bf16x8*)(kp + koff[d0]); kf[2 * d0 + 1] = *(const __attribute__((address_space(3))) bf16x8*)(kp + koff[d0] + 4096); } \
            PN0 = __builtin_amdgcn_mfma_f32_32x32x16_bf16(kf[0], qr[0], zero16, 0, 0, 0); PN1 = __builtin_amdgcn_mfma_f32_32x32x16_bf16(kf[1], qr[0], zero16, 0, 0, 0); \
            _Pragma("unroll") for (int d0 = 1; d0 < 4; ++d0) { PN0 = __builtin_amdgcn_mfma_f32_32x32x16_bf16(kf[2 * d0], qr[d0], PN0, 0, 0, 0); PN1 = __builtin_amdgcn_mfma_f32_32x32x16_bf16(kf[2 * d0 + 1], qr[d0], PN1, 0, 0, 0); } } while (0)
#define ATTA_FBEXP(PN0, PN1, ii) do { const __attribute__((address_space(3))) f32x4* bp = biasv + 16 * (ii); \
            _Pragma("unroll") for (int g = 0; g < 4; ++g) { const f32x4 b0 = bp[2 * g], b1 = bp[2 * g + 8]; \
                _Pragma("unroll") for (int e = 0; e < 4; ++e) { PN0[4 * g + e] = __builtin_amdgcn_exp2f(PN0[4 * g + e] + b0[e]); PN1[4 * g + e] = __builtin_amdgcn_exp2f(PN1[4 * g + e] + b1[e]); } } } while (0)
#define ATTA_FSUMPACK(PC0, PC1) do { l_run += rowsum32(PC0, PC1); \
            _Pragma("unroll") for (int k = 0; k < 2; ++k) { pw[k] = (u32x4){cvtpk(PC0[8 * k], PC0[8 * k + 1]), cvtpk(PC0[8 * k + 2], PC0[8 * k + 3]), cvtpk(PC0[8 * k + 4], PC0[8 * k + 5]), cvtpk(PC0[8 * k + 6], PC0[8 * k + 7])}; \
                pw[2 + k] = (u32x4){cvtpk(PC1[8 * k], PC1[8 * k + 1]), cvtpk(PC1[8 * k + 2], PC1[8 * k + 3]), cvtpk(PC1[8 * k + 4], PC1[8 * k + 5]), cvtpk(PC1[8 * k + 6], PC1[8 * k + 7])}; } } while (0)
#define ATTA_FPV(ii) do { const lds_cptr vp = (lds_cptr)(uintptr_t)(((unsigned)(uintptr_t)(vp0 + ((wid >> 1) + (ii)) * 8192)) & 0x3ffffu); \
            _Pragma("unroll") for (int ks = 0; ks < 4; ++ks) \
                _Pragma("unroll") for (int d0 = 0; d0 < 2; ++d0) { \
                    const s16x4 lo = vtr(vp + d0 * 4096 + ks * 1024), hh = vtr(vp + d0 * 4096 + ks * 1024 + 512); \
                    const bf16x8 vf = (bf16x8){lo[0], lo[1], lo[2], lo[3], hh[0], hh[1], hh[2], hh[3]}; \
                    o[d0] = __builtin_amdgcn_mfma_f32_32x32x16_bf16(__builtin_bit_cast(bf16x8, pw[ks]), vf, o[d0], 0, 0, 0); } } while (0)
            const f32x16 zero16 = f32x16{}; f32x16 pa0, pa1, pb0, pb1; u32x4 pw[4];
            ATTA_FQK(pa0, pa1, 0); ATTA_FBEXP(pa0, pa1, 0);
            ATTA_FQK(pb0, pb1, 1); ATTA_FSUMPACK(pa0, pa1); ATTA_FPV(0); ATTA_FBEXP(pb0, pb1, 1);
            ATTA_FQK(pa0, pa1, 2); ATTA_FSUMPACK(pb0, pb1); ATTA_FPV(1); ATTA_FBEXP(pa0, pa1, 2);
            ATTA_FSUMPACK(pa0, pa1); ATTA_FPV(2);
#undef ATTA_FQK
#undef ATTA_FBEXP
#undef ATTA_FSUMPACK
#undef ATTA_FPV
        } else
        for (int i = 0; i < 3; ++i) {
            const int tau = (wid >> 1) + i;
            if (tau < tau_min) continue;
            const lds_cptr kp = kp0 + tau * 8192; const lds_cptr vp = vp0 + tau * 8192;
            f32x16 p0, p1;
            { bf16x8 kf[8];
#pragma unroll
              for (int d0 = 0; d0 < 4; ++d0) { kf[2 * d0] = *(const __attribute__((address_space(3))) bf16x8*)(kp + koff[d0]); kf[2 * d0 + 1] = *(const __attribute__((address_space(3))) bf16x8*)(kp + koff[d0] + 4096); }
              __builtin_amdgcn_sched_barrier(0);
              p0 = __builtin_amdgcn_mfma_f32_32x32x16_bf16(kf[0], qr[0], negm, 0, 0, 0); p1 = __builtin_amdgcn_mfma_f32_32x32x16_bf16(kf[1], qr[0], negm, 0, 0, 0);
#pragma unroll
              for (int d0 = 1; d0 < 4; ++d0) { p0 = __builtin_amdgcn_mfma_f32_32x32x16_bf16(kf[2 * d0], qr[d0], p0, 0, 0, 0); p1 = __builtin_amdgcn_mfma_f32_32x32x16_bf16(kf[2 * d0 + 1], qr[d0], p1, 0, 0, 0); }
              __builtin_amdgcn_sched_barrier(0); }
            { const __attribute__((address_space(3))) f32x4* bp = biasv + 16 * i;
#pragma unroll
              for (int g = 0; g < 4; ++g) { const f32x4 b0 = bp[2 * g], b1 = bp[2 * g + 8];
#pragma unroll
                  for (int e = 0; e < 4; ++e) { p0[4 * g + e] += b0[e]; p1[4 * g + e] += b1[e]; } } }
            const float rm = rowmax32(p0, p1);
            if (__any(rm > THR_A)) {
                const float dl = fmaxf(rm, 0.f), f = __builtin_amdgcn_exp2f(-dl);
                mhat += dl; l_run *= f;
#pragma unroll
                for (int r = 0; r < 16; ++r) { p0[r] -= dl; p1[r] -= dl; negm[r] = -mhat; }
                asm volatile("" : "+v"(negm));
                if (hi == 0) wsf[r32] = f;
                asm volatile("s_waitcnt lgkmcnt(0)" ::: "memory");
#pragma unroll
                for (int r = 0; r < 16; ++r) { const float fr = wsf[crow(r, hi)]; o[0][r] *= fr; o[1][r] *= fr; }
            }
#pragma unroll
            for (int r = 0; r < 16; ++r) { p0[r] = __builtin_amdgcn_exp2f(p0[r]); p1[r] = __builtin_amdgcn_exp2f(p1[r]); }
            l_run += rowsum32(p0, p1);
            u32x4 pw[4];
#pragma unroll
            for (int k = 0; k < 2; ++k) { pw[k] = (u32x4){cvtpk(p0[8 * k], p0[8 * k + 1]), cvtpk(p0[8 * k + 2], p0[8 * k + 3]), cvtpk(p0[8 * k + 4], p0[8 * k + 5]), cvtpk(p0[8 * k + 6], p0[8 * k + 7])};
                pw[2 + k] = (u32x4){cvtpk(p1[8 * k], p1[8 * k + 1]), cvtpk(p1[8 * k + 2], p1[8 * k + 3]), cvtpk(p1[8 * k + 4], p1[8 * k + 5]), cvtpk(p1[8 * k + 6], p1[8 * k + 7])}; }
            { s16x4 vl[8], vh[8];
#pragma unroll
              for (int i2 = 0; i2 < 8; ++i2) { vl[i2] = vtr(vp + (i2 >> 2) * 4096 + (i2 & 3) * 1024); vh[i2] = vtr(vp + (i2 >> 2) * 4096 + (i2 & 3) * 1024 + 512); }
              __builtin_amdgcn_sched_barrier(0);
#pragma unroll
              for (int ks = 0; ks < 4; ++ks)
#pragma unroll
                  for (int d0 = 0; d0 < 2; ++d0) { const int i2 = 4 * d0 + ks;
                      const bf16x8 vf = (bf16x8){vl[i2][0], vl[i2][1], vl[i2][2], vl[i2][3], vh[i2][0], vh[i2][1], vh[i2][2], vh[i2][3]};
                      o[d0] = __builtin_amdgcn_mfma_f32_32x32x16_bf16(__builtin_bit_cast(bf16x8, pw[ks]), vf, o[d0], 0, 0, 0); }
              __builtin_amdgcn_sched_barrier(0); }
        }
        asm volatile("s_waitcnt vmcnt(0) lgkmcnt(0)\n\ts_barrier" ::: "memory");
        const UnitA cu = u;
        if (more) { u = nu; ATTA_ISSUE(u); }
        const long qtok = cu.tok0 + (long)cu.dil * (256 * cu.c + wid * 32 + r32);
        { auto rr = __builtin_amdgcn_permlane32_swap(__float_as_uint(l_run), __float_as_uint(l_run), false, false); l_run = __uint_as_float(rr[0]) + __uint_as_float(rr[1]); }
        if (hi == 0) { wsf[32 + r32] = l_run; ML[((size_t)cu.br * M + qtok) * 8 + cu.h] = make_float2(mhat, l_run); }
        asm volatile("s_waitcnt lgkmcnt(0)" ::: "memory");
        float rli[16];
#pragma unroll
        for (int r = 0; r < 16; ++r) rli[r] = 1.0f / wsf[32 + crow(r, hi)];
        { __attribute__((address_space(3))) bf16* stg = (__attribute__((address_space(3))) bf16*)(shm + L_OST) + wid * 2048;
#pragma unroll
          for (int r = 0; r < 16; ++r) { const int orow = crow(r, hi);
#pragma unroll
              for (int d0 = 0; d0 < 2; ++d0) stg[orow * 64 + d0 * 32 + r32] = (bf16)f2bf(o[d0][r] * rli[r]); }
          asm volatile("s_waitcnt lgkmcnt(0)" ::: "memory");
          bf16* Pb = PO + (size_t)cu.br * PO_STRIDE + 64 * cu.h;
#pragma unroll
          for (int i = 0; i < 4; ++i) { const int row = i * 8 + (lane >> 3), ch = lane & 7; const u32x4 v = *(const __attribute__((address_space(3))) u32x4*)(stg + row * 64 + ch * 8);
              *(u32x4*)(Pb + (cu.tok0 + (long)cu.dil * (256 * cu.c + wid * 32 + row)) * 512 + ch * 8) = v; } }
        if (!more) break;
    }
    asm volatile("s_waitcnt vmcnt(0) lgkmcnt(0)\n\ts_barrier" ::: "memory");
#undef ATTA_LOADS
#undef ATTA_ISSUE
}
}
constexpr int PER_PHASE = 8;
constexpr int N_LAUNCHES = MK_N_LAUNCHES;
struct Args { const void* in[17]; float* out; unsigned char* ws; int ph_lo, ph_hi, li, pad; };
__global__ void __launch_bounds__(NWAVES * 64, 2) fwd_kernel(Args args) {
    extern __shared__ __attribute__((aligned(16))) unsigned char lds[];
    Frame F;
    F.lds = (LAS unsigned char*)lds;
    F.MISC = (volatile LAS unsigned*)(F.lds + MISC_OFF);
    F.tid = threadIdx.x; F.lane = F.tid & 63; F.wave = __builtin_amdgcn_readfirstlane(F.tid >> 6);
    F.G = gridDim.x; { const int bx = blockIdx.x; F.vcu = (F.G % 8 == 0) ? (bx % 8) * (F.G / 8) + bx / 8 : bx; }
    unsigned char* ws = args.ws;
    F.ctl = (gu32*)(ws + WS_CTL);
    In I; I.x = (const float*)args.in[0]; I.pos = (const int*)args.in[1]; I.g_mix = (const float*)args.in[2]; I.w_in = (const float*)args.in[3]; I.g_qa = (const float*)args.in[4]; I.g_ka = (const float*)args.in[5];
    I.rel_bias = (const float*)args.in[6]; I.g_cq = (const float*)args.in[7]; I.g_ckv = (const float*)args.in[8]; I.w_uq = (const float*)args.in[9]; I.w_ukv = (const float*)args.in[10]; I.g_qb = (const float*)args.in[11];
    I.g_kb = (const float*)args.in[12]; I.w_o = (const float*)args.in[13]; I.g_ffn = (const float*)args.in[14]; I.w1 = (const float*)args.in[15]; I.w2 = (const float*)args.in[16];
    for (int u = F.tid; u < (LDS_BYTES - LDSCTL_OFF) / 4; u += NWAVES * 64) ((LAS unsigned*)(F.lds + LDSCTL_OFF))[u] = 0u;
    __syncthreads();
    XcdBarrier bar; bar.bar = (unsigned*)(F.ctl + CW_BAR); bar.x = 0; bar.st = nullptr;
    if (N_LAUNCHES != PER_PHASE) bar = xcd_barrier_post((unsigned*)(F.ctl + CW_BAR), F.MISC + 8);
#define GRID_BAR() do { if (N_LAUNCHES != PER_PHASE) xcd_barrier(bar); } while (0)
    const int lo = args.ph_lo, hi = args.ph_hi;
#define IN(k) (lo <= (k) && (k) < hi)
#define BOTH(k) (IN(k) && IN((k) + 1))
    bf16* XN = (bf16*)(ws + WS_XN);
    int sbA = -1, sbB = -1;
    if (IN(0)) { p0_prologue(F, I, ws); if (BOTH(0)) GRID_BAR(); }
    if (IN(1)) {
        pg8::Gemm g{XN, (const bf16*)(ws + WS_WIN), M, NIN_PAD, D}; pg8::StaticOrder S; S.init(M, NIN_PAD, F.G, (int)blockIdx.x);
        pg8::EpiInProj E{(bf16*)(ws + WS_QA), (bf16*)(ws + WS_KA), (bf16*)(ws + WS_VA), (bf16*)(ws + WS_CQ), (bf16*)(ws + WS_CKV), (float*)(ws + WS_KR), (float*)(ws + WS_SSQCQ), (float*)(ws + WS_SSQCKV), (float*)(ws + WS_SKR),
                         I.g_qa, I.g_ka, I.g_kb, (const float2*)(ws + WS_CS), QSCALE_A};
        const int nidle = F.G - (NIN_PAD / 256 * (M / 256)) % F.G, first = F.G - nidle; const bool filler = nidle < F.G && (int)blockIdx.x >= first;
        if (filler) { p0b_items(F, I, ws, ((int)blockIdx.x - first) * NWAVES + F.wave, nidle * NWAVES, 3); __syncthreads(); }
        pg8::gemm_phase<pg8::EpiInProj, pg8::StaticOrder, PG8_ALIGN, PG8_SP2>(F.lds + RING_OFF, g, S, E);
        if (filler) p0b_items(F, I, ws, ((int)blockIdx.x - first) * NWAVES + F.wave, nidle * NWAVES, 4);
        else if (nidle >= F.G) p0b_items(F, I, ws, F.vcu * NWAVES + F.wave, F.G * NWAVES, 0);
        if (BOTH(1)) { sbA = atta::score_bound_ok(I.g_qa, I.g_ka, I.rel_bias) ? 1 : 0; sbB = attb::score_bound_ok(I.g_qb, I.g_kb) ? 1 : 0; GRID_BAR(); }
    }
    if (IN(2)) {
        { pg8::Gemm g{(const bf16*)(ws + WS_CQ), (const bf16*)(ws + WS_WUQ), M, 768, QLR}; pg8::StaticOrder S; S.init(M, 768, F.G, (int)blockIdx.x);
          pg8::EpiRowScale<12, 768> E{(const float*)(ws + WS_SSQCQ), (bf16*)(ws + WS_QB), 768};
          pg8::gemm_phase<pg8::EpiRowScale<12, 768>, pg8::StaticOrder, PG8_ALIGN, PG8_SP2>(F.lds + RING_OFF, g, S, E);
        }
        { pg8::Gemm g{(const bf16*)(ws + WS_CKV), (const bf16*)(ws + WS_WUKV), M, 1024, KVLR}; pg8::StaticOrder S; S.init(M, 1024, F.G, (int)blockIdx.x);
          pg8::EpiKV E{(const float*)(ws + WS_SSQCKV), (const float*)(ws + WS_SKR), (const float*)(ws + WS_KR), I.g_kb, (bf16*)(ws + WS_KBN), (bf16*)(ws + WS_KBR), (bf16*)(ws + WS_VB)};
          pg8::gemm_phase<pg8::EpiKV, pg8::StaticOrder, PG8_ALIGN, PG8_SP2>(F.lds + RING_OFF, g, S, E);
        }
        atta::phase<0>(lds, (unsigned*)(F.ctl + CW_AQ), (const bf16*)(ws + WS_QA), (const bf16*)(ws + WS_KA), (const bf16*)(ws + WS_VA), (const float*)(ws + WS_BIAS), (bf16*)args.out, (float2*)(ws + WS_ML), (sbA < 0 ? atta::score_bound_ok(I.g_qa, I.g_ka, I.rel_bias) : sbA != 0));
        if (BOTH(2)) GRID_BAR();
    }
    if (IN(4)) {
        attb::phase<0>(lds, F.vcu, F.G, (const bf16*)(ws + WS_QB), (const bf16*)(ws + WS_KBN), (const bf16*)(ws + WS_KBR), (const bf16*)(ws + WS_VB), (bf16*)(ws + WS_MIX), I.g_qb, (const float2*)(ws + WS_CS), (const bf16*)args.out, (const float2*)(ws + WS_ML), (sbB < 0 ? attb::score_bound_ok(I.g_qb, I.g_kb) : sbB != 0));
        if (BOTH(4)) GRID_BAR(); }
    if (IN(5)) {
        pg8::Gemm g{(const bf16*)(ws + WS_MIX), (const bf16*)(ws + WS_WO), M, D, D}; pg8::StaticOrder S; S.init(M, D, F.G, (int)blockIdx.x);
        pg8::EpiWo E{I.x, args.out, (bf16*)(ws + WS_H1B), (float*)(ws + WS_SSQH), D};
        pg8::gemm_phase<pg8::EpiWo, pg8::StaticOrder, PG8_ALIGN, PG8_SP2>(F.lds + RING_OFF, g, S, E);
        if (BOTH(5)) GRID_BAR();
    }
    if (IN(6)) {
        if (F.vcu & 1) { p0b_items(F, I, ws, (F.vcu >> 1) * NWAVES + F.wave, (F.G >> 1) * NWAVES, 1); __syncthreads(); }
        pg8::Gemm g{(const bf16*)(ws + WS_H1B), (const bf16*)(ws + WS_W1), M, FF, D}; pg8::StaticOrder S; S.init(M, FF, F.G, (int)blockIdx.x);
        pg8::EpiRelu2 E{(const float*)(ws + WS_SSQH), (bf16*)(ws + WS_HID), FF};
        pg8::gemm_phase<pg8::EpiRelu2, pg8::StaticOrder, PG8_ALIGN, PG8_SP2>(F.lds + RING_OFF, g, S, E);
        if (BOTH(6)) GRID_BAR();
    }
    if (IN(7)) {
        pg8::Gemm g{(const bf16*)(ws + WS_HID), (const bf16*)(ws + WS_W2), M, D, FF}; pg8::StaticOrder S; S.init(M, D, F.G, (int)blockIdx.x);
        pg8::EpiF32ResB E{(const bf16*)(ws + WS_H1B), args.out, D};
        pg8::gemm_phase<pg8::EpiF32ResB, pg8::StaticOrder, PG8_ALIGN, PG8_SP2>(F.lds + RING_OFF, g, S, E);
    }
#undef IN
#undef BOTH
}

extern "C" void kernel_launch(void* const* d_in, const int* in_sizes, int n_in, void* d_out, int out_size, void* d_ws, size_t ws_size, hipStream_t stream) {
    static int grid = 0;
    if (grid == 0) {
        if (n_in != 17 || out_size != M * D || ws_size < WS_END) { fprintf(stderr, "kernel_launch: unexpected problem shape (n_in %d out %d ws %zu)\n", n_in, out_size, ws_size); grid = -1; return; }
        int dev = 0, cus = 0, per_cu = 0;
        if (hipGetDevice(&dev) != hipSuccess || hipDeviceGetAttribute(&cus, hipDeviceAttributeMultiprocessorCount, dev) != hipSuccess) { grid = -1; return; }
        if (hipFuncSetAttribute((const void*)fwd_kernel, hipFuncAttributeMaxDynamicSharedMemorySize, LDS_BYTES) != hipSuccess) { fprintf(stderr, "kernel_launch: hipFuncSetAttribute failed\n"); grid = -1; return; }
        if (hipOccupancyMaxActiveBlocksPerMultiprocessor(&per_cu, (const void*)fwd_kernel, NWAVES * 64, LDS_BYTES) != hipSuccess || per_cu < 1) { fprintf(stderr, "kernel_launch: occupancy query says %d\n", per_cu); (void)hipGetLastError(); grid = -1; return; }
        grid = cus;
    }
    if (grid < 0) return;
    (void)hipMemsetAsync((char*)d_ws + WS_CTL, 0, CTL_ZERO_BYTES, stream);
    Args a{};
    for (int i = 0; i < 17; ++i) a.in[i] = d_in[i];
    a.out = (float*)d_out; a.ws = (unsigned char*)d_ws;
    if (N_LAUNCHES == 1) { a.ph_lo = 0; a.ph_hi = PER_PHASE; a.li = 0; hipLaunchKernelGGL(fwd_kernel, dim3(grid), dim3(NWAVES * 64), LDS_BYTES, stream, a); }
    else for (int li = 0; li < PER_PHASE; ++li) { a.ph_lo = li; a.ph_hi = li + 1; a.li = li; hipLaunchKernelGGL(fwd_kernel, dim3(grid), dim3(NWAVES * 64), LDS_BYTES, stream, a); }
}
```

```cpp
#include <hip/hip_runtime.h>
#include <cstdio>
#include <cstdint>
namespace pg8 {
#define PG8_LAS __attribute__((address_space(3)))
typedef unsigned short bf16_t;
typedef short bf16x8 __attribute__((ext_vector_type(8)));
typedef float f32x4 __attribute__((ext_vector_type(4)));
typedef unsigned u32x4 __attribute__((ext_vector_type(4)));
constexpr int BM = 256, BK = 64, HALF = 128, HTB = HALF * BK * 2  , STAGE_BYTES = 8 * HTB, NXCD = 8, WGM = 8;

__host__ __device__ __forceinline__ int lds_byte(int r, int c) { const int st = (r >> 4) * 2 + (c >> 5), rr = r & 15, cc = c & 31, ob = rr * 64 + cc * 2; return st * 1024 + (ob ^ (((ob >> 9) & 1) << 5)); }
__host__ __device__ __forceinline__ void stage_rc(int b, int& R, int& C) { const int st = b / 1024, sb = b % 1024, swz = sb ^ (((sb >> 9) & 1) << 5); R = (st >> 1) * 16 + swz / 64; C = (st & 1) * 32 + (swz % 64) / 2; }
__host__ __device__ __forceinline__ int perm32(int rho) { const int n = rho >> 4, i = rho & 15; return 8 * (i >> 2) + 4 * n + (i & 3); }

struct Unit { int pm, pn; };
struct Gemm { const bf16_t* A; const bf16_t* Bt; int M, N, K; };

struct StaticOrder {
    int nM, nN, nwg, G, c;
    __host__ __device__ void init(int M, int N, int G_, int c_) { nM = M / BM; nN = N / BM; nwg = nM * nN; G = G_; c = c_; }
    __host__ __device__ bool next(int i, Unit& u) const {
        const long L = (long)i * G + c; if (L >= nwg) return false;
        int wgid = (int)L; { const int q = nwg / NXCD, r = nwg % NXCD, xcd = wgid % NXCD, off = wgid / NXCD; wgid = (xcd < r ? xcd * (q + 1) : r * (q + 1) + (xcd - r) * q) + off; }
        const int nig = WGM * nN, gid = wgid / nig, fm = gid * WGM, gsz = (nM - fm) < WGM ? (nM - fm) : WGM;
        u.pm = fm + ((wgid % nig) % gsz); u.pn = (wgid % nig) / gsz; return true;
    }
    __device__ __forceinline__ void a_ready(const Unit&) const {}
    __device__ __forceinline__ void done(const Unit&) const {}
};

__device__ __forceinline__ unsigned cvt_pk_bf16(float lo, float hi) { unsigned r; asm volatile("v_cvt_pk_bf16_f32 %0, %1, %2" : "=v"(r) : "v"(lo), "v"(hi)); return r; }
__device__ __forceinline__ u32x4 pack8(const f32x4 v0, const f32x4 v1) { u32x4 w; w.x = cvt_pk_bf16(v0[0], v0[1]); w.y = cvt_pk_bf16(v0[2], v0[3]); w.z = cvt_pk_bf16(v1[0], v1[1]); w.w = cvt_pk_bf16(v1[2], v1[3]); return w; }

struct EpiInProj {
    static constexpr bool PERM = true, AFTER_DRAIN = false;
    bf16_t *QA, *KA, *VA, *CQ, *CKV; float *KR, *SSQ_CQ, *SSQ_CKV, *SKR; const float *g_qa, *g_ka, *g_kb; const float2* CS; float qscale;
    __device__ __forceinline__ void operator()(const f32x4 (&acc)[2][2][4][2], const Unit& u, int wr, int wc, int fr_, int fq_) const {
        int fr = fr_, fq = fq_; asm volatile("" : "+v"(fr), "+v"(fq));
        const int pn = u.pn; const int row0 = u.pm * BM + wr * 64 + fr;
        if (pn < 4) {
            const bool isq = pn < 2; bf16_t* base = (isq ? QA : KA) + 256 * (pn & 1) + 64 * wc + 8 * fq; const float* g = (isq ? g_qa : g_ka) + 8 * fq; const float sc = isq ? qscale : 1.0f;
            f32x4 gv[2][2];
#pragma unroll
            for (int bj = 0; bj < 2; ++bj)
#pragma unroll
                for (int n = 0; n < 2; ++n) gv[bj][n] = *(const f32x4*)(g + 32 * bj + 4 * n) * sc;
#pragma unroll
            for (int ai = 0; ai < 2; ++ai)
#pragma unroll
                for (int m = 0; m < 4; ++m) { float ss = 0.f;
#pragma unroll
                    for (int bj = 0; bj < 2; ++bj)
#pragma unroll
                        for (int n = 0; n < 2; ++n) { const f32x4 x = acc[ai][bj][m][n]; ss += (x[0] * x[0] + x[1] * x[1]) + (x[2] * x[2] + x[3] * x[3]); }
                    ss += __shfl_xor(ss, 16); ss += __shfl_xor(ss, 32);
                    const float rstd = 1.0f / sqrtf(ss * (1.0f / 64.0f) + 1e-6f);
                    bf16_t* rowp = base + (size_t)(row0 + ai * HALF + m * 16) * 512;
#pragma unroll
                    for (int bj = 0; bj < 2; ++bj) *(u32x4*)(rowp + 32 * bj) = pack8(acc[ai][bj][m][0] * rstd * gv[bj][0], acc[ai][bj][m][1] * rstd * gv[bj][1]); }
        } else if (pn < 10) {
            bf16_t* base; int ldc; float* ssq = nullptr; int sld = 0;
            if (pn < 6) { base = VA + 256 * (pn - 4); ldc = 512; } else if (pn < 9) { base = CQ + 256 * (pn - 6); ldc = 768; ssq = SSQ_CQ + 4 * (pn - 6) + wc; sld = 12; } else { base = CKV; ldc = 256; ssq = SSQ_CKV + wc; sld = 4; }
            base += 64 * wc + 8 * fq;
#pragma unroll
            for (int ai = 0; ai < 2; ++ai)
#pragma unroll
                for (int m = 0; m < 4; ++m) { const int row = row0 + ai * HALF + m * 16; bf16_t* rowp = base + (size_t)row * ldc;
#pragma unroll
                    for (int bj = 0; bj < 2; ++bj) *(u32x4*)(rowp + 32 * bj) = pack8(acc[ai][bj][m][0], acc[ai][bj][m][1]);
                    if (ssq) { float ss = 0.f;
#pragma unroll
                        for (int bj = 0; bj < 2; ++bj)
#pragma unroll
                            for (int n = 0; n < 2; ++n) { const f32x4 x = acc[ai][bj][m][n]; ss += (x[0] * x[0] + x[1] * x[1]) + (x[2] * x[2] + x[3] * x[3]); }
                        ss += __shfl_xor(ss, 16); ss += __shfl_xor(ss, 32);
                        if (fq == 0) ssq[(size_t)row * sld] = ss; } }
        } else if (wc == 0) {
            const int d0 = 8 * fq;
#pragma unroll
            for (int ai = 0; ai < 2; ++ai)
#pragma unroll
                for (int m = 0; m < 4; ++m) { const int row = row0 + ai * HALF + m * 16; float ss = 0.f;
#pragma unroll
                    for (int bj = 0; bj < 2; ++bj)
#pragma unroll
                        for (int n = 0; n < 2; ++n) { const f32x4 x = acc[ai][bj][m][n]; ss += (x[0] * x[0] + x[1] * x[1]) + (x[2] * x[2] + x[3] * x[3]); }
                    if (fq >= 2) ss = 0.f;
                    ss += __shfl_xor(ss, 16); ss += __shfl_xor(ss, 32);
                    if (fq == 0) SKR[row] = ss;
                    if (fq < 2) {
#pragma unroll
                        for (int n = 0; n < 2; ++n) { const f32x4 g1 = *(const f32x4*)(g_kb + 64 + d0 + 4 * n), g2 = *(const f32x4*)(g_kb + 80 + d0 + 4 * n);
                            const f32x4 y1 = acc[ai][0][m][n] * g1, y2 = acc[ai][1][m][n] * g2; f32x4 o1, o2;
#pragma unroll
                            for (int i = 0; i < 4; ++i) { const float2 cs = CS[(size_t)row * 16 + d0 + 4 * n + i]; o1[i] = y1[i] * cs.x - y2[i] * cs.y; o2[i] = y2[i] * cs.x + y1[i] * cs.y; }
                            *(f32x4*)(KR + (size_t)row * 32 + d0 + 4 * n) = o1; *(f32x4*)(KR + (size_t)row * 32 + 16 + d0 + 4 * n) = o2; } } }
        }
    }
};
struct EpiWo {
    static constexpr bool PERM = true, AFTER_DRAIN = false;
    const float* base; const float* IRX; const float* IG; bf16_t* H1B; float* SSQ; int ldc; bool use_xn;
    __device__ __forceinline__ void operator()(const f32x4 (&acc)[2][2][4][2], const Unit& u, int wr, int wc, int fr_, int fq_) const {
        int fr = fr_, fq = fq_; asm volatile("" : "+v"(fr), "+v"(fq));
        const int row0 = u.pm * BM + wr * 64 + fr, col0 = u.pn * BM + wc * 32 + 8 * fq;
        f32x4 ig[2][2]; float own[2];
        if (use_xn) {
#pragma unroll
            for (int bj = 0; bj < 2; ++bj) { ig[bj][0] = *(const f32x4*)(IG + col0 + bj * HALF); ig[bj][1] = *(const f32x4*)(IG + col0 + bj * HALF + 4); }
#pragma unroll
            for (int ai = 0; ai < 2; ++ai) own[ai] = IRX[row0 + ai * HALF + fq * 16];
        }
#define EPIWO_ROW(X0, X1) do { const f32x4 h0 = (X0) + acc[ai][bj][m][0], h1 = (X1) + acc[ai][bj][m][1]; \
            *(u32x4*)(H1B + off + bj * HALF) = pack8(h0, h1); \
            ss += (h0[0] * h0[0] + h0[1] * h0[1]) + (h0[2] * h0[2] + h0[3] * h0[3]) + (h1[0] * h1[0] + h1[1] * h1[1]) + (h1[2] * h1[2] + h1[3] * h1[3]); } while (0)
#pragma unroll
        for (int ai = 0; ai < 2; ++ai) {
            if (use_xn) {
                u32x4 xn[4][2];
#pragma unroll
                for (int m = 0; m < 4; ++m)
#pragma unroll
                    for (int bj = 0; bj < 2; ++bj) xn[m][bj] = *(const u32x4*)(H1B + (size_t)(row0 + ai * HALF + m * 16) * ldc + col0 + bj * HALF);
                asm volatile("" ::: "memory");
#pragma unroll
                for (int m = 0; m < 4; ++m) { const int row = row0 + ai * HALF + m * 16; const size_t off = (size_t)row * ldc + col0; float ss = 0.f; const float irx = __shfl(own[ai], fr + 16 * m);
#pragma unroll
                    for (int bj = 0; bj < 2; ++bj) { const u32x4 w = xn[m][bj]; f32x4 x0, x1;
                        x0[0] = __uint_as_float(w.x << 16); x0[1] = __uint_as_float(w.x & 0xffff0000u); x0[2] = __uint_as_float(w.y << 16); x0[3] = __uint_as_float(w.y & 0xffff0000u);
                        x1[0] = __uint_as_float(w.z << 16); x1[1] = __uint_as_float(w.z & 0xffff0000u); x1[2] = __uint_as_float(w.w << 16); x1[3] = __uint_as_float(w.w & 0xffff0000u);
                        EPIWO_ROW(x0 * (ig[bj][0] * irx), x1 * (ig[bj][1] * irx)); }
                    ss += __shfl_xor(ss, 16); ss += __shfl_xor(ss, 32);
                    if (fq == 0) SSQ[(size_t)row * 16 + 4 * u.pn + wc] = ss; }
            } else {
                f32x4 xb[4][2][2];
#pragma unroll
                for (int m = 0; m < 4; ++m)
#pragma unroll
                    for (int bj = 0; bj < 2; ++bj) { const float* p = base + (size_t)(row0 + ai * HALF + m * 16) * ldc + col0 + bj * HALF; xb[m][bj][0] = *(const f32x4*)p; xb[m][bj][1] = *(const f32x4*)(p + 4); }
                asm volatile("" ::: "memory");
#pragma unroll
                for (int m = 0; m < 4; ++m) { const int row = row0 + ai * HALF + m * 16; const size_t off = (size_t)row * ldc + col0; float ss = 0.f;
#pragma unroll
                    for (int bj = 0; bj < 2; ++bj) EPIWO_ROW(xb[m][bj][0], xb[m][bj][1]);
                    ss += __shfl_xor(ss, 16); ss += __shfl_xor(ss, 32);
                    if (fq == 0) SSQ[(size_t)row * 16 + 4 * u.pn + wc] = ss; }
            }
            asm volatile("" ::: "memory");
        }
#undef EPIWO_ROW
    }
};
template <int NS, int KD> __device__ __forceinline__ float rstd_slots(const float* ssq, int row) {
    const f32x4* sp = (const f32x4*)(ssq + (size_t)row * NS); f32x4 s4 = sp[0];
#pragma unroll
    for (int i = 1; i < NS / 4; ++i) s4 += sp[i];
    return 1.0f / sqrtf(((s4[0] + s4[1]) + (s4[2] + s4[3])) * (1.0f / (float)KD) + 1e-6f);
}
template <int NS, int KD> __device__ __forceinline__ void rstd_rows8(const float* ssq, int row0, int fr, int fq, float (&rs)[2][4]) {
    float own[2];
#pragma unroll
    for (int ai = 0; ai < 2; ++ai) own[ai] = rstd_slots<NS, KD>(ssq, row0 + ai * HALF + fq * 16);
    const int l15 = fr;
#pragma unroll
    for (int ai = 0; ai < 2; ++ai)
#pragma unroll
        for (int m = 0; m < 4; ++m) rs[ai][m] = __shfl(own[ai], l15 + 16 * m);
}
template <int NS, int KD> struct EpiRowScale {
    static constexpr bool PERM = true, AFTER_DRAIN = false;
    const float* ssq; bf16_t* O; int ldc;
    __device__ __forceinline__ void operator()(const f32x4 (&acc)[2][2][4][2], const Unit& u, int wr, int wc, int fr_, int fq_) const {
        int fr = fr_, fq = fq_; asm volatile("" : "+v"(fr), "+v"(fq));
        const int row0 = u.pm * BM + wr * 64 + fr, col0 = u.pn * BM + wc * 32 + 8 * fq;
        float rs[2][4]; rstd_rows8<NS, KD>(ssq, row0, fr, fq, rs);
#pragma unroll
        for (int ai = 0; ai < 2; ++ai)
#pragma unroll
            for (int m = 0; m < 4; ++m) { const int row = row0 + ai * HALF + m * 16; const float s = rs[ai][m]; bf16_t* rowp = O + (size_t)row * ldc + col0;
#pragma unroll
                for (int bj = 0; bj < 2; ++bj) *(u32x4*)(rowp + bj * HALF) = pack8(acc[ai][bj][m][0] * s, acc[ai][bj][m][1] * s); }
    }
};
struct EpiKV {
    static constexpr bool PERM = true, AFTER_DRAIN = false;
    const float *SSQ_CKV, *SKR, *KR, *g_kb; bf16_t *KBN, *KBR, *VB;
    __device__ __forceinline__ void operator()(const f32x4 (&acc)[2][2][4][2], const Unit& u, int wr, int wc, int fr_, int fq_) const {
        int fr = fr_, fq = fq_; asm volatile("" : "+v"(fr), "+v"(fq));
        const int row0 = u.pm * BM + wr * 64 + fr, h = 2 * u.pn + (wc >> 1);
        float rs_own[2], skr_own[2];
#pragma unroll
        for (int ai = 0; ai < 2; ++ai) { rs_own[ai] = rstd_slots<4, 256>(SSQ_CKV, row0 + ai * HALF + fq * 16); skr_own[ai] = SKR[row0 + ai * HALF + fq * 16]; }
        if (wc & 1) {
#pragma unroll
            for (int ai = 0; ai < 2; ++ai)
#pragma unroll
                for (int m = 0; m < 4; ++m) { const int row = row0 + ai * HALF + m * 16; const float s = __shfl(rs_own[ai], fr + 16 * m); bf16_t* rowp = VB + (size_t)row * 512 + 64 * h + 8 * fq;
#pragma unroll
                    for (int bj = 0; bj < 2; ++bj) *(u32x4*)(rowp + 32 * bj) = pack8(acc[ai][bj][m][0] * s, acc[ai][bj][m][1] * s); }
        } else {
            f32x4 gk[2][2];
#pragma unroll
            for (int bj = 0; bj < 2; ++bj) { gk[bj][0] = *(const f32x4*)(g_kb + 32 * bj + 8 * fq); gk[bj][1] = *(const f32x4*)(g_kb + 32 * bj + 8 * fq + 4); }
#pragma unroll
            for (int ai = 0; ai < 2; ++ai) {
              f32x4 kr[4][2];
#pragma unroll
              for (int m = 0; m < 4; ++m) { const float* p = KR + (size_t)(row0 + ai * HALF + m * 16) * 32 + 8 * fq; kr[m][0] = *(const f32x4*)p; kr[m][1] = *(const f32x4*)(p + 4); }
              asm volatile("" ::: "memory");
#pragma unroll
                for (int m = 0; m < 4; ++m) { const int row = row0 + ai * HALF + m * 16; const float s = __shfl(rs_own[ai], fr + 16 * m), skr = __shfl(skr_own[ai], fr + 16 * m); float ss = 0.f;
#pragma unroll
                    for (int bj = 0; bj < 2; ++bj)
#pragma unroll
                        for (int n = 0; n < 2; ++n) { const f32x4 x = acc[ai][bj][m][n]; ss += (x[0] * x[0] + x[1] * x[1]) + (x[2] * x[2] + x[3] * x[3]); }
                    ss += __shfl_xor(ss, 16); ss += __shfl_xor(ss, 32);
                    const float rk = 1.0f / sqrtf((ss * s * s + skr) * (1.0f / 96.0f) + 1e-6f), sr = s * rk;
                    bf16_t* rowp = KBN + (size_t)row * 512 + 64 * h + 8 * fq;
#pragma unroll
                    for (int bj = 0; bj < 2; ++bj) *(u32x4*)(rowp + 32 * bj) = pack8(acc[ai][bj][m][0] * sr * gk[bj][0], acc[ai][bj][m][1] * sr * gk[bj][1]);
                    *(u32x4*)(KBR + (size_t)row * 256 + 32 * h + 8 * fq) = pack8(kr[m][0] * rk, kr[m][1] * rk); }
              asm volatile("" ::: "memory"); }
        }
    }
};
struct EpiF32ResB {
    static constexpr bool PERM = true, AFTER_DRAIN = false;
    const bf16_t* baseb; float* out; int ldc;
    __device__ __forceinline__ void operator()(const f32x4 (&acc)[2][2][4][2], const Unit& u, int wr, int wc, int fr_, int fq_) const {
        int fr = fr_, fq = fq_; asm volatile("" : "+v"(fr), "+v"(fq));
        const int row0 = u.pm * BM + wr * 64 + fr, col0 = u.pn * BM + wc * 32 + 8 * fq;
        u32x4 bb[2][4][2];
#pragma unroll
        for (int ai = 0; ai < 2; ++ai)
#pragma unroll
            for (int m = 0; m < 4; ++m)
#pragma unroll
                for (int bj = 0; bj < 2; ++bj) bb[ai][m][bj] = *(const u32x4*)(baseb + (size_t)(row0 + ai * HALF + m * 16) * ldc + col0 + bj * HALF);
        asm volatile("" ::: "memory");
#pragma unroll
        for (int ai = 0; ai < 2; ++ai)
#pragma unroll
            for (int m = 0; m < 4; ++m) { const size_t off = (size_t)(row0 + ai * HALF + m * 16) * ldc + col0;
#pragma unroll
                for (int bj = 0; bj < 2; ++bj) { const u32x4 b = bb[ai][m][bj];
                    f32x4 b0, b1; b0[0] = __uint_as_float(b.x << 16); b0[1] = __uint_as_float(b.x & 0xffff0000u); b0[2] = __uint_as_float(b.y << 16); b0[3] = __uint_as_float(b.y & 0xffff0000u);
                    b1[0] = __uint_as_float(b.z << 16); b1[1] = __uint_as_float(b.z & 0xffff0000u); b1[2] = __uint_as_float(b.w << 16); b1[3] = __uint_as_float(b.w & 0xffff0000u);
                    *(f32x4*)(out + off + bj * HALF) = b0 + acc[ai][bj][m][0]; *(f32x4*)(out + off + bj * HALF + 4) = b1 + acc[ai][bj][m][1]; } }
    }
};
struct EpiRelu2 {
    static constexpr bool PERM = true, AFTER_DRAIN = false;
    const float* ssq; bf16_t* O; int ldc;
    const PG8_LAS float* rsl; int pm_cached;
    __device__ __forceinline__ void operator()(const f32x4 (&acc)[2][2][4][2], const Unit& u, int wr, int wc, int fr_, int fq_) const {
        int fr = fr_, fq = fq_; asm volatile("" : "+v"(fr), "+v"(fq));
        const int row0 = u.pm * BM + wr * 64 + fr, col0 = u.pn * BM + wc * 64 + 8 * fq;
        float rs[2][4];
        if (u.pm == pm_cached) {
#pragma unroll
            for (int ai = 0; ai < 2; ++ai)
#pragma unroll
                for (int m = 0; m < 4; ++m) rs[ai][m] = rsl[wr * 64 + fr + ai * HALF + m * 16];
        } else rstd_rows8<16, 1024>(ssq, row0, fr, fq, rs);
#pragma unroll
        for (int ai = 0; ai < 2; ++ai)
#pragma unroll
            for (int m = 0; m < 4; ++m) { const int row = row0 + ai * HALF + m * 16; const float s = rs[ai][m]; bf16_t* rowp = O + (size_t)row * ldc + col0;
#pragma unroll
                for (int bj = 0; bj < 2; ++bj) { f32x4 v0 = acc[ai][bj][m][0] * s, v1 = acc[ai][bj][m][1] * s;
#pragma unroll
                    for (int i = 0; i < 4; ++i) { const float a = fmaxf(v0[i], 0.f), b = fmaxf(v1[i], 0.f); v0[i] = a * a; v1[i] = b * b; }
                    *(u32x4*)(rowp + bj * 32) = pack8(v0, v1); } }
    }
};
template <class Epi, class Sched, bool ALIGN_EPI = false, bool SP2 = false>
__device__ __forceinline__ void gemm_phase(PG8_LAS unsigned char* lds, const Gemm g, const Sched& S, const Epi& E) {
    int tid_ = threadIdx.x; asm volatile("" : "+v"(tid_));
    const int tid = tid_, wid = __builtin_amdgcn_readfirstlane(tid >> 6), lane = tid & 63, wr = wid >> 2, wc = wid & 3, fr = lane & 15, fq = lane >> 4;
    const int K = g.K, nt = K / BK;
    unsigned voffA[2], voffB[2];
#pragma unroll
    for (int i = 0; i < 2; ++i) { int R, C; stage_rc(tid * 16 + i * 8192, R, C); const int Rb = Epi::PERM ? ((R & ~31) + perm32(R & 31)) : R;
        voffA[i] = (unsigned)(R * K + C) * 2u; voffB[i] = (unsigned)(Rb * K + C) * 2u; }
    const size_t kstep = (size_t)(BK * 2);
    const size_t hstep = (size_t)HALF * K * 2;
    const size_t tstep = 2 * hstep;
    const unsigned ldsw = (unsigned)wid * 1024u;
    const int aoff = lds_byte(wr * 64 + fr, fq * 8), boff = lds_byte(wc * 32 + fr, fq * 8);
#define PG8_SA(b, h) (((b) * 2 + (h)) * HTB)
#define PG8_SB(b, h) ((4 + (b) * 2 + (h)) * HTB)
#define PG8_STAGE(bufoff, gbase, voff) do { _Pragma("unroll") for (int _i = 0; _i < 2; ++_i) \
        __builtin_amdgcn_global_load_lds((const unsigned*)((const char*)(gbase) + (voff)[_i]), (PG8_LAS unsigned*)(lds + (bufoff) + ldsw + _i * 8192), 16, 0, 0); } while (0)
#define PG8_LDA(dst, b, h) do { _Pragma("unroll") for (int m = 0; m < 4; ++m) _Pragma("unroll") for (int k = 0; k < 2; ++k) dst[m][k] = *(const PG8_LAS bf16x8*)(lds + PG8_SA(b, h) + aoff + m * 2048 + k * 1024); } while (0)
#define PG8_LDB(dst, b, h) do { _Pragma("unroll") for (int n = 0; n < 2; ++n) _Pragma("unroll") for (int k = 0; k < 2; ++k) dst[n][k] = *(const PG8_LAS bf16x8*)(lds + PG8_SB(b, h) + boff + n * 2048 + k * 1024); } while (0)
#define PG8_MMA(ai, bj, At, Bt) do { __builtin_amdgcn_s_setprio(1); _Pragma("unroll") for (int m = 0; m < 4; ++m) _Pragma("unroll") for (int n = 0; n < 2; ++n) _Pragma("unroll") for (int k = 0; k < 2; ++k) \
        acc[ai][bj][m][n] = __builtin_amdgcn_mfma_f32_16x16x32_bf16(Bt[n][k], At[m][k], acc[ai][bj][m][n], 0, 0, 0); __builtin_amdgcn_s_setprio(0); } while (0)
#define PG8_WAIT_V(n) asm volatile("s_waitcnt vmcnt(" #n ")" ::: "memory")
#define PG8_WAIT_L(n) asm volatile("s_waitcnt lgkmcnt(" #n ")" ::: "memory")
#define PG8_BAR __builtin_amdgcn_s_barrier()
#define PG8_SCHED __builtin_amdgcn_sched_barrier(0)
    Unit cur, nxt; int ui = 0;
    if (!S.next(0, cur)) return;
    f32x4 acc[2][2][4][2];
#pragma unroll
    for (int a = 0; a < 2; ++a)
#pragma unroll
        for (int b = 0; b < 2; ++b)
#pragma unroll
            for (int m = 0; m < 4; ++m)
#pragma unroll
                for (int n = 0; n < 2; ++n) acc[a][b][m][n] = (f32x4){0.f, 0.f, 0.f, 0.f};
    bf16x8 At[4][2], B0[2][2], B1[2][2];
    const char* cA = (const char*)g.A + (size_t)cur.pm * tstep; const char* cB = (const char*)g.Bt + (size_t)cur.pn * tstep;
    S.a_ready(cur);
    if constexpr (SP2) {
        PG8_STAGE(PG8_SB(0, 0), cB, voffB); PG8_STAGE(PG8_SB(0, 1), cB + hstep, voffB); PG8_STAGE(PG8_SA(0, 0), cA, voffA); PG8_STAGE(PG8_SA(0, 1), cA + hstep, voffA);
        if (wr == 1) PG8_BAR;
        PG8_WAIT_V(2); PG8_BAR;
        PG8_STAGE(PG8_SB(1, 0), cB + kstep, voffB); PG8_STAGE(PG8_SA(1, 0), cA + kstep, voffA); PG8_STAGE(PG8_SB(1, 1), cB + hstep + kstep, voffB);
        PG8_WAIT_V(6); PG8_BAR;
    } else {
        PG8_STAGE(PG8_SB(0, 0), cB, voffB); PG8_STAGE(PG8_SA(0, 0), cA, voffA); PG8_STAGE(PG8_SB(0, 1), cB + hstep, voffB); PG8_STAGE(PG8_SA(0, 1), cA + hstep, voffA);
        if (wr == 1) PG8_BAR;
        PG8_WAIT_V(4); PG8_BAR;
        PG8_STAGE(PG8_SB(1, 0), cB + kstep, voffB); PG8_STAGE(PG8_SA(1, 0), cA + kstep, voffA); PG8_STAGE(PG8_SB(1, 1), cB + hstep + kstep, voffB);
        PG8_WAIT_V(6); PG8_BAR;
    }
    for (;;) {
        const bool has_next = S.next(ui + 1, nxt);
        const char* nA = has_next ? (const char*)g.A + (size_t)nxt.pm * tstep : cA; const char* nB = has_next ? (const char*)g.Bt + (size_t)nxt.pn * tstep : cB;
        for (int t = 0; t < nt; t += 2) {
            const bool last = (t == nt - 2);
            const char* a1 = cA + (size_t)(t + 1) * kstep;
            const char* a2 = last ? nA : cA + (size_t)(t + 2) * kstep; const char* b2 = last ? nB : cB + (size_t)(t + 2) * kstep;
            const char* a3 = a2 + kstep; const char* b3 = b2 + kstep;
            if (last && has_next) S.a_ready(nxt);
            if constexpr (SP2) {
            PG8_LDB(B0, 0, 0); PG8_LDB(B1, 0, 1); PG8_SCHED; PG8_LDA(At, 0, 0); PG8_STAGE(PG8_SA(1, 1), a1 + hstep, voffA);
            PG8_WAIT_V(8); PG8_WAIT_L(0); PG8_BAR; PG8_MMA(0, 0, At, B0); PG8_MMA(0, 1, At, B1); PG8_BAR; PG8_SCHED;
            PG8_LDA(At, 0, 1); PG8_STAGE(PG8_SB(0, 0), b2, voffB); PG8_STAGE(PG8_SB(0, 1), b2 + hstep, voffB); PG8_STAGE(PG8_SA(0, 0), a2, voffA);
            PG8_WAIT_V(8); PG8_WAIT_L(0); PG8_BAR; PG8_MMA(1, 0, At, B0); PG8_MMA(1, 1, At, B1); PG8_BAR; PG8_SCHED;
            PG8_LDB(B0, 1, 0); PG8_LDB(B1, 1, 1); PG8_SCHED; PG8_LDA(At, 1, 0); PG8_STAGE(PG8_SA(0, 1), a2 + hstep, voffA);
            PG8_WAIT_V(8); PG8_WAIT_L(0); PG8_BAR; PG8_MMA(0, 0, At, B0); PG8_MMA(0, 1, At, B1); PG8_BAR; PG8_SCHED;
            PG8_LDA(At, 1, 1); PG8_STAGE(PG8_SB(1, 0), b3, voffB); PG8_STAGE(PG8_SB(1, 1), b3 + hstep, voffB); PG8_STAGE(PG8_SA(1, 0), a3, voffA);
            PG8_WAIT_V(8); PG8_WAIT_L(0); PG8_BAR; PG8_MMA(1, 0, At, B0); PG8_MMA(1, 1, At, B1); PG8_BAR; PG8_SCHED;
            } else {
            PG8_LDB(B0, 0, 0); PG8_SCHED; PG8_LDA(At, 0, 0); PG8_STAGE(PG8_SA(1, 1), a1 + hstep, voffA);
            PG8_WAIT_L(8); PG8_BAR; PG8_WAIT_L(0); PG8_MMA(0, 0, At, B0); PG8_BAR; PG8_SCHED;
            PG8_LDB(B1, 0, 1); PG8_STAGE(PG8_SB(0, 0), b2, voffB);
            PG8_BAR; PG8_WAIT_L(0); PG8_MMA(0, 1, At, B1); PG8_BAR;
            PG8_LDA(At, 0, 1); PG8_STAGE(PG8_SA(0, 0), a2, voffA);
            PG8_BAR; PG8_WAIT_L(0); PG8_MMA(1, 0, At, B0); PG8_BAR; PG8_SCHED;
            PG8_STAGE(PG8_SB(0, 1), b2 + hstep, voffB);
            PG8_WAIT_V(6); PG8_BAR; PG8_MMA(1, 1, At, B1); PG8_BAR;
            PG8_LDB(B0, 1, 0); PG8_SCHED; PG8_LDA(At, 1, 0); PG8_STAGE(PG8_SA(0, 1), a2 + hstep, voffA);
            PG8_WAIT_L(8); PG8_BAR; PG8_WAIT_L(0); PG8_MMA(0, 0, At, B0); PG8_BAR; PG8_SCHED;
            PG8_LDB(B1, 1, 1); PG8_STAGE(PG8_SB(1, 0), b3, voffB);
            PG8_BAR; PG8_WAIT_L(0); PG8_MMA(0, 1, At, B1); PG8_BAR;
            PG8_LDA(At, 1, 1); PG8_STAGE(PG8_SA(1, 0), a3, voffA);
            PG8_BAR; PG8_WAIT_L(0); PG8_MMA(1, 0, At, B0); PG8_BAR; PG8_SCHED;
            PG8_STAGE(PG8_SB(1, 1), b3 + hstep, voffB);
            PG8_WAIT_V(6); PG8_BAR; PG8_MMA(1, 1, At, B1); PG8_BAR;
            }
        }
        if constexpr (ALIGN_EPI) { if (wr == 0) PG8_BAR; }
        if constexpr (!Epi::AFTER_DRAIN) { E(acc, cur, wr, wc, fr, fq); S.done(cur); }
        if (!has_next) break;
#pragma unroll
        for (int a = 0; a < 2; ++a)
#pragma unroll
            for (int b = 0; b < 2; ++b)
#pragma unroll
                for (int m = 0; m < 4; ++m)
#pragma unroll
                    for (int n = 0; n < 2; ++n) acc[a][b][m][n] = (f32x4){0.f, 0.f, 0.f, 0.f};
        cur = nxt; cA = nA; cB = nB; ++ui;
        if constexpr (ALIGN_EPI) { if (wr == 1) PG8_BAR; }
    }
    PG8_WAIT_V(0);
    if constexpr (!ALIGN_EPI) { if (wr == 0) PG8_BAR; }
    PG8_BAR;
    if constexpr (Epi::AFTER_DRAIN) { E.fused(acc, cur, wr, wc, fr, fq, lds, wid, lane); S.done(cur); }
#undef PG8_SA
#undef PG8_SB
#undef PG8_STAGE
#undef PG8_LDA
#undef PG8_LDB
#undef PG8_MMA
#undef PG8_WAIT_V
#undef PG8_WAIT_L
#undef PG8_BAR
#undef PG8_SCHED
}
}
#ifndef PG8_SP2
#define PG8_SP2 true
#endif
#ifndef PG8_ALIGN
#define PG8_ALIGN true
#endif
constexpr int NWAVES = 8;
#ifndef MK_N_LAUNCHES
#define MK_N_LAUNCHES 1
#endif
#define UKV_MAP 1
constexpr int BATCH = 4, SEQ = 4096, D = 1024, M = BATCH * SEQ, FF = 4096;
constexpr int HA = 8, DA = 64, WA = 512;
constexpr int HB = 8, DN = 64, DR = 32, DQK = 96, DV = 64;
constexpr int QLR = 768, KVLR = 256;
constexpr int NIN = 2592, NIN_PAD = 2816;
constexpr float EPS = 1e-6f;
constexpr float LOG2E = 1.4426950408889634f;
constexpr float QSCALE_A = 0.125f * LOG2E;
constexpr float QSCALE_B = 0.10206207261596575f * LOG2E;

constexpr size_t MiB = 1u << 20;
constexpr size_t WS_CTL = 0, CTL_ZERO_BYTES = 32 * 1024;
constexpr size_t WS_WIN = 1 * MiB;
constexpr size_t WS_WUQ = 7 * MiB;
constexpr size_t WS_WUKV = 8 * MiB + 512 * 1024;
constexpr size_t WS_WO = 9 * MiB;
constexpr size_t WS_W1 = 11 * MiB;
constexpr size_t WS_W2 = 19 * MiB;
constexpr size_t WS_CS = 27 * MiB;
constexpr size_t WS_KR = 29 * MiB;
constexpr size_t WS_SSQCQ = 31 * MiB;
constexpr size_t WS_SKR = 31 * MiB + 768 * 1024;
constexpr size_t WS_BIAS = 31 * MiB + 832 * 1024;
constexpr size_t WS_SSQCKV = 32 * MiB;
constexpr size_t WS_IRX = 32 * MiB + 512 * 1024;
constexpr size_t WS_SSQH = 27 * MiB;
constexpr size_t WS_ML = 33 * MiB;
constexpr size_t WS_XN = 36 * MiB;
constexpr size_t WS_H1B = 36 * MiB;
constexpr size_t WS_QA = 68 * MiB, WS_KA = 84 * MiB, WS_VA = 100 * MiB;
constexpr size_t WS_CQ = 116 * MiB;
constexpr size_t WS_CKV = 140 * MiB;
constexpr size_t WS_MIX = 116 * MiB;
constexpr size_t WS_QB = 148 * MiB;
constexpr size_t WS_KBN = 172 * MiB;
constexpr size_t WS_KBR = 188 * MiB;
constexpr size_t WS_VB = 196 * MiB;
constexpr size_t WS_HID = 128 * MiB;
constexpr size_t WS_END = 256 * MiB;

constexpr int CW_TMO = 0, CW_CODE = 1;
constexpr int CW_BAR = 4096;
constexpr int CW_AQ = 2048;
constexpr int RING_OFF = 0, RING_BYTES = 131072;
constexpr int LDSCTL_OFF = 139264, MISC_OFF = LDSCTL_OFF + 320;
constexpr int LDS_BYTES = 147456;
#define GAS __attribute__((address_space(1)))
#define LAS __attribute__((address_space(3)))
typedef unsigned short bf16;
typedef unsigned v4u __attribute__((ext_vector_type(4)));
typedef float f32x4 __attribute__((ext_vector_type(4)));
typedef short bf16x8 __attribute__((ext_vector_type(8)));
typedef GAS unsigned gu32;
typedef GAS unsigned long long gu64;
#define RLX_AGENT __ATOMIC_RELAXED, __HIP_MEMORY_SCOPE_AGENT
#define LDS_WAIT() asm volatile("s_waitcnt lgkmcnt(0)" ::: "memory")
#define VM_WAIT() asm volatile("s_waitcnt vmcnt(0)" ::: "memory")
__device__ __forceinline__ unsigned long long rt() { return __builtin_amdgcn_s_memrealtime(); }
__device__ __forceinline__ unsigned f2bf(float f) { unsigned u = __builtin_bit_cast(unsigned, f); return (u + 0x7fffu + ((u >> 16) & 1u)) >> 16; }
__device__ __forceinline__ unsigned pk2(float lo, float hi) { return f2bf(lo) | (f2bf(hi) << 16); }

#define XB_TMO      128
#define XB_XCNT(j)  (256  + 64 * (j))
#define XB_XSUB(j)  (1280 + 64 * (j))
#define XB_XGEN(j)  (2304 + 64 * (j))
#define XB_TOP      3328
#define XB_TOPGEN   3392
#define XCD_BAR_WORDS 3456
#define XB_SPIN_CAP (1u << 18)

__device__ __forceinline__ unsigned xb_ld(unsigned* p)              { return __hip_atomic_load(p, __ATOMIC_RELAXED, __HIP_MEMORY_SCOPE_AGENT); }
__device__ __forceinline__ unsigned xb_add(unsigned* p, unsigned v) { return __hip_atomic_fetch_add(p, v, __ATOMIC_RELAXED, __HIP_MEMORY_SCOPE_AGENT); }
__device__ __forceinline__ unsigned xb_xcc_id() { return (unsigned)__builtin_amdgcn_s_getreg((3 << 11) | 20) & 0xFu; }
#define XB_SPIN(cond, bar) do { unsigned _sp = 0; while (cond) { __builtin_amdgcn_s_sleep(1); \
    if ((++_sp & 255u) == 0u) { if (xb_ld(&(bar)[XB_TMO])) break; if (_sp > XB_SPIN_CAP) { atomicAdd(&(bar)[XB_TMO], 1u); break; } } } } while (0)

struct XcdBarrier {
    unsigned* bar; unsigned x;
    volatile LAS unsigned* st;
};

__device__ __forceinline__ XcdBarrier xcd_barrier_post(unsigned* bar, volatile LAS unsigned* st) {
    XcdBarrier b; b.bar = bar; b.x = xb_xcc_id(); b.st = st;
    if (threadIdx.x == 0) (void)xb_add(&bar[XB_XCNT(b.x)], 1u);
    return b;
}
__device__ __forceinline__ void xcd_barrier_complete(unsigned* bar, unsigned x, unsigned& nloc, unsigned& nx) {
    const unsigned G = gridDim.x * gridDim.y * gridDim.z;
    unsigned sum, cnt, mine, sp = 0u;
    for (;;) {
        sum = 0u; cnt = 0u; mine = 0u;
#pragma unroll
        for (unsigned j = 0; j < 16; ++j) { const unsigned c = xb_ld(&bar[XB_XCNT(j)]); sum += c; cnt += (c > 0u) ? 1u : 0u; mine = (j == x) ? c : mine; }
        if (sum == G) break;
        __builtin_amdgcn_s_sleep(1);
        if ((++sp & 255u) == 0u) { if (xb_ld(&bar[XB_TMO])) break; if (sp > XB_SPIN_CAP) { atomicAdd(&bar[XB_TMO], 1u); break; } }
    }
    nloc = mine > 0u ? mine : 1u; nx = cnt > 0u ? cnt : 1u;
}

__device__ __forceinline__ void xcd_barrier(const XcdBarrier& b) {
    asm volatile("s_waitcnt vmcnt(0)" ::: "memory");
    __syncthreads();
    if (threadIdx.x == 0) {
        unsigned* bar = b.bar;
        __builtin_amdgcn_s_waitcnt(0);
        unsigned nloc = b.st[0], nx = b.st[1];
        if (nloc == 0u) { xcd_barrier_complete(bar, b.x, nloc, nx); b.st[0] = nloc; b.st[1] = nx; }
        const unsigned old = xb_add(&bar[XB_XSUB(b.x)], 1u);
        const unsigned gen = old / nloc;
        if (old + 1u == (gen + 1u) * nloc) {
            __builtin_amdgcn_fence(__ATOMIC_RELEASE, "agent");
            asm volatile("s_waitcnt vmcnt(0)" ::: "memory");
            const unsigned og = xb_add(&bar[XB_TOP], 1u);
            const unsigned tg = og / nx;
            if (og + 1u == (tg + 1u) * nx) xb_add(&bar[XB_TOPGEN], 1u);
            else XB_SPIN(xb_ld(&bar[XB_TOPGEN]) == tg, bar);
            __builtin_amdgcn_fence(__ATOMIC_ACQUIRE, "agent");
            asm volatile("s_waitcnt vmcnt(0)" ::: "memory");
        } else {
            XB_SPIN(xb_ld(&bar[XB_TOPGEN]) == gen, bar);
            __builtin_amdgcn_fence(__ATOMIC_ACQUIRE, "agent");
            asm volatile("s_waitcnt vmcnt(0)" ::: "memory");
        }
    }
    __syncthreads();
}
struct Frame {
    LAS unsigned char* lds;
    volatile LAS unsigned* MISC;
    gu32* ctl;
    int tid, lane, wave;
    int vcu, G;
};
__device__ __forceinline__ float wave_sum(float v) {
#pragma unroll
    for (int o = 1; o < 64; o <<= 1) v += __shfl_xor(v, o);
    return v;
}
__device__ __forceinline__ float bf2f(unsigned short u) { return __uint_as_float((unsigned)u << 16); }
__device__ __forceinline__ float bflo(unsigned w) { return __uint_as_float(w << 16); }
__device__ __forceinline__ float bfhi(unsigned w) { return __uint_as_float(w & 0xffff0000u); }

__device__ __forceinline__ int rowmap_sigma(int n) { if (n >= 2560) { const int d = n - 2560; return 2560 + (d < 16 ? d : 112 + d); } const int c = n & 255; return (n & ~255) + 128 * ((c >> 5) & 1) + 32 * (c >> 6) + (c & 31); }
template <int MAP> __device__ __forceinline__ void p0_transpose_item(const float* W, int K, int N, bf16* WT, const float* kscale, LAS float* scr, int item, int lane) {
    const int nblk = N / 32, kb = item / nblk, nb = item % nblk, k0 = 64 * kb, n0 = 32 * nb;
    f32x4 w[8]; const int rr = lane >> 3, c4 = (lane & 7) * 4;
#pragma unroll
    for (int i = 0; i < 8; ++i) w[i] = *(const GAS f32x4*)(W + (size_t)(k0 + 8 * i + rr) * N + n0 + c4);
#pragma unroll
    for (int i = 0; i < 8; ++i) { const int kk = 8 * i + rr; f32x4 v = w[i]; if (kscale) v = v * kscale[k0 + kk];
        scr[kk * 33 + c4] = v.x; scr[kk * 33 + c4 + 1] = v.y; scr[kk * 33 + c4 + 2] = v.z; scr[kk * 33 + c4 + 3] = v.w; }
    LDS_WAIT(); asm volatile("" ::: "memory");
    const int c = lane & 7;
#pragma unroll
    for (int j = 0; j < 4; ++j) { const int n = (lane >> 3) + 8 * j; const LAS float* s = scr + (8 * c) * 33 + n;
        v4u o; o.x = pk2(s[0 * 33], s[1 * 33]); o.y = pk2(s[2 * 33], s[3 * 33]); o.z = pk2(s[4 * 33], s[5 * 33]); o.w = pk2(s[6 * 33], s[7 * 33]);
        const int drow = MAP == 2 ? ((((n0 + n) & ~255) + 128 * (((n0 + n) >> 5) & 1) + 32 * (((n0 + n) & 255) >> 6) + ((n0 + n) & 31))) : (MAP ? rowmap_sigma(n0 + n) : (n0 + n)); *(GAS v4u*)(WT + (size_t)drow * K + k0 + 8 * c) = o; }
    LDS_WAIT(); asm volatile("" ::: "memory");
}
struct In { const float* x; const int* pos; const float *g_mix, *w_in, *g_qa, *g_ka, *rel_bias, *g_cq, *g_ckv, *w_uq, *w_ukv, *g_qb, *g_kb, *w_o, *g_ffn, *w1, *w2; };

__device__ __forceinline__ float inv_freq(int k) {
    const float t[16] = {1.000000000e+00f, 5.623413324e-01f, 3.162277639e-01f, 1.778279394e-01f, 1.000000015e-01f, 5.623413250e-02f, 3.162277490e-02f, 1.778279431e-02f,
                         9.999999776e-03f, 5.623413250e-03f, 3.162277630e-03f, 1.778279431e-03f, 1.000000047e-03f, 5.623413017e-04f, 3.162277571e-04f, 1.778279402e-04f};
    float r = t[0];
#pragma unroll
    for (int i = 1; i < 16; ++i) r = (k == i) ? t[i] : r;
    return r;
}
__device__ __forceinline__ int t5_bucket(int dist) {
    if (dist < 16) return dist;
    int l = 16 + (int)(logf((float)dist * (1.0f / 16.0f)) / 4.852030263919617f * 16.0f);
    return l < 31 ? l : 31;
}
constexpr int I_IN = (D / 64) * (NIN / 32), I_UQ = (QLR / 64) * (768 / 32), I_UKV = (KVLR / 64) * (1024 / 32), I_O = (D / 64) * (D / 32), I_1 = (D / 64) * (FF / 32), I_2 = (FF / 64) * (D / 32);
__device__ __forceinline__ void p0b_items(Frame& F, const In& I, unsigned char* ws, int gw, int NGW, int part) {
    LAS float* scr = (LAS float*)(F.lds + RING_OFF + F.wave * 16384);
    bf16* Wuq = (bf16*)(ws + WS_WUQ); bf16* Wukv = (bf16*)(ws + WS_WUKV); bf16* Wo = (bf16*)(ws + WS_WO); bf16* W1 = (bf16*)(ws + WS_W1); bf16* W2 = (bf16*)(ws + WS_W2);
    if (part == 1) { for (int it = gw; it < I_2; it += NGW) p0_transpose_item<0>(I.w2, FF, D, W2, nullptr, scr, it, F.lane); return; }
    constexpr int NITEMS = I_UQ + I_UKV + I_O + I_1;
    const int it_lo = (part == 4) ? NITEMS / 2 : 0, it_hi = (part == 3) ? NITEMS / 2 : NITEMS;
    for (int it = it_lo + gw; it < it_hi; it += NGW) {
        int r = it;
        if (r < I_UQ) { p0_transpose_item<0>(I.w_uq, QLR, 768, Wuq, I.g_cq, scr, r, F.lane); continue; } r -= I_UQ;
        if (r < I_UKV) { p0_transpose_item<UKV_MAP>(I.w_ukv, KVLR, 1024, Wukv, I.g_ckv, scr, r, F.lane); continue; } r -= I_UKV;
        if (r < I_O) { p0_transpose_item<0>(I.w_o, D, D, Wo, nullptr, scr, r, F.lane); continue; } r -= I_O;
        p0_transpose_item<2>(I.w1, D, FF, W1, I.g_ffn, scr, r, F.lane);
    }
}
__device__ __forceinline__ void p0_prologue(Frame& F, const In& I, unsigned char* ws) {
    LAS float* scr = (LAS float*)(F.lds + RING_OFF + F.wave * 16384);
    const int gw = F.vcu * NWAVES + F.wave, NGW = F.G * NWAVES;
    const int gt = gw * 64 + F.lane, NGT = NGW * 64;
    bf16* Win = (bf16*)(ws + WS_WIN);
    for (int it = gw; it < I_IN; it += NGW) p0_transpose_item<1>(I.w_in, D, NIN, Win, nullptr, scr, it, F.lane);
    { const int n16 = 112 * D * 2 / 16; GAS v4u* z0 = (GAS v4u*)(Win + (size_t)(2560 + 16) * D); GAS v4u* z1 = (GAS v4u*)(Win + (size_t)(2560 + 144) * D);
      for (int i = gt; i < n16; i += NGT) { z0[i] = (v4u){0u, 0u, 0u, 0u}; z1[i] = (v4u){0u, 0u, 0u, 0u}; } }
    bf16* XN = (bf16*)(ws + WS_XN);
    f32x4 g[4];
#pragma unroll
    for (int j = 0; j < 4; ++j) g[j] = *((const GAS f32x4*)I.g_mix + F.lane + 64 * j);
    for (int m0 = gw * 4; m0 < M; m0 += NGW * 4) {
        f32x4 v[4][4];
#pragma unroll
        for (int r = 0; r < 4; ++r)
#pragma unroll
            for (int j = 0; j < 4; ++j) v[r][j] = *((const GAS f32x4*)(I.x + (size_t)(m0 + r) * D) + F.lane + 64 * j);
#pragma unroll
        for (int r = 0; r < 4; ++r) { float s2 = 0.f;
#pragma unroll
            for (int j = 0; j < 4; ++j) s2 += (v[r][j].x * v[r][j].x + v[r][j].y * v[r][j].y) + (v[r][j].z * v[r][j].z + v[r][j].w * v[r][j].w);
            const float sd_ = sqrtf(wave_sum(s2) * (1.f / D) + EPS); const float rstd = 1.f / sd_;
            if (F.lane == 0) ((float*)(ws + WS_IRX))[m0 + r] = sd_;
            GAS unsigned long long* o8 = (GAS unsigned long long*)(XN + (size_t)(m0 + r) * D) + F.lane;
#pragma unroll
            for (int j = 0; j < 4; ++j) o8[64 * j] = (unsigned long long)pk2(v[r][j].x * rstd * g[j].x, v[r][j].y * rstd * g[j].y) | ((unsigned long long)pk2(v[r][j].z * rstd * g[j].z, v[r][j].w * rstd * g[j].w) << 32); }
    }
    { float* IG = (float*)(ws + WS_IRX + 65536); for (int i = gt; i < D; i += NGT) IG[i] = 1.f / I.g_mix[i]; }
    { float2* CS = (float2*)(ws + WS_CS);
      for (int i = gt; i < M * 16; i += NGT) { const int m = i >> 4, k = i & 15; const float ang = (float)I.pos[m] * inv_freq(k);
          const double a = (double)ang; const double n = __builtin_rint(a * 0.15915494309189535); const float r = (float)(a - n * 6.283185307179586);
          CS[i] = make_float2(__cosf(r), __sinf(r)); } }
    { float* BT = (float*)(ws + WS_BIAS);
      for (int i = gt; i < 3 * 8 * 132; i += NGT) { const int br = i / (8 * 132), h = (i / 132) % 8, j = i % 132; const int dil = br == 0 ? 1 : (br == 1 ? 4 : 16);
          BT[i] = j <= 128 ? I.rel_bias[t5_bucket(dil * j) * 8 + h] * LOG2E : 0.f; } }
}
namespace attb {
using bf16x8 = __attribute__((ext_vector_type(8))) short;
using s16x4 = __attribute__((ext_vector_type(4))) short;
using f32x16 = __attribute__((ext_vector_type(16))) float;
using u32x4 = __attribute__((ext_vector_type(4))) unsigned;
typedef short v4i16_t __attribute__((ext_vector_type(4)));
typedef __attribute__((address_space(3))) const char* lds_cptr;
typedef __attribute__((address_space(3))) char* lds_ptr;
constexpr int QB_ROWS = 256, KVBLK = 64, NQB = SEQ / QB_ROWS;
constexpr int KSLOT = 12288, VSLOT = 8192, NSLOT = 3;
constexpr int NVSLOT = 3, NKSLOT = 4;
constexpr int L_K = 0, L_V = NKSLOT * KSLOT, L_WS = L_V + NVSLOT * VSLOT, L_OST = L_WS + NWAVES * 256, L_BYTES = L_OST + NWAVES * 4096;
constexpr float THR = 6.0f;
constexpr float THR_B = 24.0f;
__device__ __forceinline__ int crow(int r, int hi) { return (r & 3) + 8 * (r >> 2) + 4 * hi; }
__device__ __forceinline__ void glds16(const void* gsrc, unsigned lds_dst) { unsigned keep;
    asm volatile("s_mov_b32 %0, m0\n\ts_mov_b32 m0, %2\n\ts_nop 0\n\tglobal_load_lds_dwordx4 %1, off\n\ts_mov_b32 m0, %0" : "=&s"(keep) : "v"(gsrc), "s"(lds_dst) : "memory"); }
typedef float f32x2_t __attribute__((ext_vector_type(2))); typedef __bf16 bf16x2_t __attribute__((ext_vector_type(2)));
__device__ __forceinline__ unsigned cvtpk(float lo, float hi) { f32x2_t v = {lo, hi}; bf16x2_t b = __builtin_convertvector(v, bf16x2_t); return __builtin_bit_cast(unsigned, b); }
__device__ __forceinline__ s16x4 vtr(lds_cptr p) { return __builtin_bit_cast(s16x4, __builtin_amdgcn_ds_read_tr16_b64_v4i16((__attribute__((address_space(3))) v4i16_t*)p)); }
__device__ __forceinline__ float max3f(float a, float b, float c) { float r; asm("v_max3_f32 %0, %1, %2, %3" : "=v"(r) : "v"(a), "v"(b), "v"(c)); return r; }
__device__ __forceinline__ float max2f(float a, float b) { float r; asm("v_max_f32_e32 %0, %1, %2" : "=v"(r) : "v"(a), "v"(b)); return r; }
__device__ __forceinline__ float fadd_s(float a, float b) { float r; asm("v_add_f32_e32 %0, %1, %2" : "=v"(r) : "v"(a), "v"(b)); return r; }
#define MX3(a, b, c) max3f((a), (b), (c))
__device__ __forceinline__ float rowmax32(const f32x16& p0, const f32x16& p1) {
    const float a0 = MX3(p0[0], p0[1], p0[2]), a1 = MX3(p0[3], p0[4], p0[5]), a2 = MX3(p0[6], p0[7], p0[8]), a3 = MX3(p0[9], p0[10], p0[11]), a4 = MX3(p0[12], p0[13], p0[14]);
    const float a5 = MX3(p1[0], p1[1], p1[2]), a6 = MX3(p1[3], p1[4], p1[5]), a7 = MX3(p1[6], p1[7], p1[8]), a8 = MX3(p1[9], p1[10], p1[11]), a9 = MX3(p1[12], p1[13], p1[14]);
    const float a10 = max2f(p0[15], p1[15]);
    const float b0 = MX3(a0, a1, a2), b1 = MX3(a3, a4, a5), b2 = MX3(a6, a7, a8), b3 = MX3(a9, a10, a10);
    const float m = max2f(MX3(b0, b1, b2), b3);
    auto rr = __builtin_amdgcn_permlane32_swap(__float_as_uint(m), __float_as_uint(m), false, false);
    return max2f(__uint_as_float(rr[0]), __uint_as_float(rr[1]));
}
__device__ __forceinline__ float rowsum32(const f32x16& p0, const f32x16& p1) {
    float t[16];
#pragma unroll
    for (int r = 0; r < 16; ++r) t[r] = fadd_s(p0[r], p1[r]);
#pragma unroll
    for (int r = 0; r < 8; ++r) t[r] = fadd_s(t[r], t[r + 8]);
#pragma unroll
    for (int r = 0; r < 4; ++r) t[r] = fadd_s(t[r], t[r + 4]);
    return fadd_s(fadd_s(t[0], t[2]), fadd_s(t[1], t[3]));
}
#define ATTB_WAIT_BAR(N) asm volatile("s_waitcnt vmcnt(" #N ") lgkmcnt(0)\n\ts_barrier" ::: "memory")
template <int VAR> __device__ __forceinline__ void unit(int b, int h, int qb, const bf16* Q, const bf16* KN, const bf16* KR, const bf16* V, bf16* O, lds_ptr shm, const float* g_qb, const float2* CS, const bf16* PO, const float2* ML, const bool fast) {
    int tid_ = threadIdx.x; asm volatile("" : "+v"(tid_));
    const int tid = tid_, lane = tid & 63, r32 = lane & 31, hi = lane >> 5; const int wid = __builtin_amdgcn_readfirstlane(tid >> 6);
    const long rowbase = (long)b * SEQ; const int q0 = qb * QB_ROWS;
    const unsigned lds0 = (unsigned)(uintptr_t)shm;
    __attribute__((address_space(3))) float* wsf = (__attribute__((address_space(3))) float*)(shm + L_WS) + wid * 64;
    const int krow = wid * 8 + (lane >> 3), rrow = (wid & 3) * 16 + (lane >> 2);
    const bf16* ksrc0 = KN + (rowbase + krow) * 512 + 64 * h + (((lane & 7) ^ ((krow >> 1) & 7)) * 8);
    const bf16* ksrc1 = KR + (rowbase + rrow) * 256 + 32 * h + (((lane & 3) ^ ((rrow >> 2) & 3)) * 8);
    const bf16* vsrc = V + (rowbase + 16 * (wid & 3) + (lane >> 2)) * 512 + 64 * h + (wid >> 2) * 32 + (lane & 3) * 8;
    const unsigned kdst0 = lds0 + L_K + wid * 1024, kdst1 = lds0 + L_K + 8192 + (wid & 3) * 1024, vdst = lds0 + L_V + wid * 1024;
#define ATTB_DMA_K(t, ks_) do { glds16(ksrc0 + (long)(t) * KVBLK * 512, (unsigned)__builtin_amdgcn_readfirstlane(kdst0 + (ks_) * KSLOT)); \
        if (wid < 4) glds16(ksrc1 + (long)(t) * KVBLK * 256, (unsigned)__builtin_amdgcn_readfirstlane(kdst1 + (ks_) * KSLOT)); } while (0)
#define ATTB_DMA_V(t, vs_) glds16(vsrc + (long)(t) * KVBLK * 512, (unsigned)__builtin_amdgcn_readfirstlane(vdst + (vs_) * VSLOT))
#define ATTB_DMA(t, ks_, vs_) do { ATTB_DMA_K(t, ks_); ATTB_DMA_V(t, vs_); } while (0)
    const int NT = (q0 + QB_ROWS) / KVBLK;
    ATTB_DMA(0, 0, 0); ATTB_DMA(1, 1, 1); if (fast) ATTB_DMA_K(2, 2);
    bf16x8 qr[6];
    { const long tok = rowbase + q0 + wid * 32 + r32; const bf16* Qw = Q + tok * 768 + 96 * h + hi * 8;
      float qv[6][8]; float ss = 0.f;
#pragma unroll
      for (int d0 = 0; d0 < 6; ++d0) { const u32x4 raw = *reinterpret_cast<const u32x4*>(Qw + d0 * 16);
          qv[d0][0] = bflo(raw.x); qv[d0][1] = bfhi(raw.x); qv[d0][2] = bflo(raw.y); qv[d0][3] = bfhi(raw.y); qv[d0][4] = bflo(raw.z); qv[d0][5] = bfhi(raw.z); qv[d0][6] = bflo(raw.w); qv[d0][7] = bfhi(raw.w);
#pragma unroll
          for (int j = 0; j < 8; ++j) ss += qv[d0][j] * qv[d0][j]; }
      ss += __shfl_xor(ss, 32);
      const float rstd = 1.0f / sqrtf(ss * (1.0f / 96.0f) + EPS);
#pragma unroll
      for (int d0 = 0; d0 < 6; ++d0) { const f32x4 g0 = *(const f32x4*)(g_qb + 16 * d0 + 8 * hi), g1 = *(const f32x4*)(g_qb + 16 * d0 + 8 * hi + 4);
#pragma unroll
          for (int j = 0; j < 4; ++j) { qv[d0][j] *= rstd * g0[j]; qv[d0][4 + j] *= rstd * g1[j]; } }
#pragma unroll
      for (int j = 0; j < 8; ++j) { const float2 cs = CS[tok * 16 + 8 * hi + j]; const float x1 = qv[4][j], x2 = qv[5][j]; qv[4][j] = x1 * cs.x - x2 * cs.y; qv[5][j] = x2 * cs.x + x1 * cs.y; }
#pragma unroll
      for (int d0 = 0; d0 < 6; ++d0) { const u32x4 w = (u32x4){cvtpk(qv[d0][0] * QSCALE_B, qv[d0][1] * QSCALE_B), cvtpk(qv[d0][2] * QSCALE_B, qv[d0][3] * QSCALE_B), cvtpk(qv[d0][4] * QSCALE_B, qv[d0][5] * QSCALE_B), cvtpk(qv[d0][6] * QSCALE_B, qv[d0][7] * QSCALE_B)};
          qr[d0] = __builtin_bit_cast(bf16x8, w); } }
    float mhat = 0.f, l_run = 0.f; f32x16 o[2]; o[0] = f32x16{}; o[1] = f32x16{};
    const int qrel = wid * 32 + r32;
    const lds_cptr kp0 = (lds_cptr)shm + L_K + r32 * 128, kr0 = (lds_cptr)shm + L_K + 8192 + r32 * 64;
    int koff[6];
#pragma unroll
    for (int d0 = 0; d0 < 4; ++d0) koff[d0] = ((2 * d0 + hi) ^ ((r32 >> 1) & 7)) * 16;
#pragma unroll
    for (int d0 = 4; d0 < 6; ++d0) koff[d0] = ((2 * (d0 - 4) + hi) ^ ((r32 >> 2) & 3)) * 16;
    const lds_cptr vp0 = (lds_cptr)shm + L_V + ((lane >> 4) & 1) * 32 + (lane & 3) * 8 + (4 * hi + ((lane & 15) >> 2)) * 64;
    f32x16 p0, p1; const f32x16 zero16 = f32x16{};
#define ATTB_SKIP(tt) (((tt) - (NT - 4)) >= 1 && wid < 2 * ((tt) - (NT - 4)))
#define ATTB_QK(tt, sl) do { if (!ATTB_SKIP(tt)) { const lds_cptr kp = kp0 + (sl) * KSLOT, kr = kr0 + (sl) * KSLOT; \
        bf16x8 kf[12];     \
        _Pragma("unroll") for (int d0 = 0; d0 < 6; ++d0) { const lds_cptr ka = (d0 < 4 ? kp : kr) + koff[d0]; \
            kf[2 * d0] = *(const __attribute__((address_space(3))) bf16x8*)(ka); kf[2 * d0 + 1] = *(const __attribute__((address_space(3))) bf16x8*)(ka + (d0 < 4 ? 4096 : 2048)); } \
        __builtin_amdgcn_sched_barrier(0); \
        p0 = __builtin_amdgcn_mfma_f32_32x32x16_bf16(kf[0], qr[0], zero16, 0, 0, 0); p1 = __builtin_amdgcn_mfma_f32_32x32x16_bf16(kf[1], qr[0], zero16, 0, 0, 0); \
        _Pragma("unroll") for (int d0 = 1; d0 < 6; ++d0) { p0 = __builtin_amdgcn_mfma_f32_32x32x16_bf16(kf[2 * d0], qr[d0], p0, 0, 0, 0); p1 = __builtin_amdgcn_mfma_f32_32x32x16_bf16(kf[2 * d0 + 1], qr[d0], p1, 0, 0, 0); } \
        __builtin_amdgcn_sched_barrier(0); \
        const int jb_ = (tt) - (NT - 4); \
        if (jb_ >= 0) { const int kb = 64 * jb_ + 4 * hi; \
            _Pragma("unroll") for (int r = 0; r < 16; ++r) { const int kv = kb + (r & 3) + 8 * (r >> 2); if (kv > qrel) p0[r] = -INFINITY; if (kv + 32 > qrel) p1[r] = -INFINITY; } } } } while (0)
#define ATTB_SMPV(tt, sl) do { if (!ATTB_SKIP(tt)) { const lds_cptr vp = vp0 + (sl) * VSLOT; \
        float rm = rowmax32(p0, p1);        \
        if (__any(rm - mhat > THR_B)) { \
            const float dl = fmaxf(rm - mhat, 0.f), f = __builtin_amdgcn_exp2f(-dl); \
            mhat += dl; l_run *= f; \
            if (hi == 0) wsf[r32] = f; \
            asm volatile("s_waitcnt lgkmcnt(0)" ::: "memory"); \
            _Pragma("unroll") for (int r = 0; r < 16; ++r) { const float fr = wsf[crow(r, hi)]; o[0][r] *= fr; o[1][r] *= fr; } \
        } \
        if (__any(mhat != 0.f)) { _Pragma("unroll") for (int r = 0; r < 16; ++r) { p0[r] -= mhat; p1[r] -= mhat; } } \
        _Pragma("unroll") for (int r = 0; r < 16; ++r) { p0[r] = __builtin_amdgcn_exp2f(p0[r]); p1[r] = __builtin_amdgcn_exp2f(p1[r]); } \
        l_run += rowsum32(p0, p1); \
        u32x4 pw[4]; \
        _Pragma("unroll") for (int k = 0; k < 2; ++k) { pw[k] = (u32x4){cvtpk(p0[8 * k], p0[8 * k + 1]), cvtpk(p0[8 * k + 2], p0[8 * k + 3]), cvtpk(p0[8 * k + 4], p0[8 * k + 5]), cvtpk(p0[8 * k + 6], p0[8 * k + 7])}; \
            pw[2 + k] = (u32x4){cvtpk(p1[8 * k], p1[8 * k + 1]), cvtpk(p1[8 * k + 2], p1[8 * k + 3]), cvtpk(p1[8 * k + 4], p1[8 * k + 5]), cvtpk(p1[8 * k + 6], p1[8 * k + 7])}; } \
        s16x4 vl[8], vh[8];     \
        _Pragma("unroll") for (int i = 0; i < 8; ++i) { vl[i] = vtr(vp + (i >> 2) * 4096 + (i & 3) * 1024); vh[i] = vtr(vp + (i >> 2) * 4096 + (i & 3) * 1024 + 512); } \
        __builtin_amdgcn_sched_barrier(0); \
        _Pragma("unroll") for (int ks = 0; ks < 4; ++ks) \
            _Pragma("unroll") for (int d0 = 0; d0 < 2; ++d0) { const int i = 4 * d0 + ks; \
                const bf16x8 vf = (bf16x8){vl[i][0], vl[i][1], vl[i][2], vl[i][3], vh[i][0], vh[i][1], vh[i][2], vh[i][3]}; \
                o[d0] = __builtin_amdgcn_mfma_f32_32x32x16_bf16(__builtin_bit_cast(bf16x8, pw[ks]), vf, o[d0], 0, 0, 0); } \
        __builtin_amdgcn_sched_barrier(0); } } while (0)
    if (!fast) {
    for (int i = 0; i < NT; ++i) {
        if (i + 1 < NT) { if (wid < 4) ATTB_WAIT_BAR(3); else ATTB_WAIT_BAR(2); } else ATTB_WAIT_BAR(0);
        if (i + 2 < NT) ATTB_DMA(i + 2, (i + 2) % 3, (i + 2) % 3);
        ATTB_QK(i, i % 3);
        ATTB_SMPV(i, i % 3);
    }
    } else {
#define ATTB_FQK(PN0, PN1, tt) do { const lds_cptr kp = kp0 + ((tt) & 3) * KSLOT, kr = kr0 + ((tt) & 3) * KSLOT; \
        bf16x8 ka_[6], kb_[6]; \
        _Pragma("unroll") for (int d0 = 0; d0 < 3; ++d0) { ka_[2 * d0] = *(const __attribute__((address_space(3))) bf16x8*)(kp + koff[d0]); ka_[2 * d0 + 1] = *(const __attribute__((address_space(3))) bf16x8*)(kp + koff[d0] + 4096); } \
        kb_[0] = *(const __attribute__((address_space(3))) bf16x8*)(kp + koff[3]); kb_[1] = *(const __attribute__((address_space(3))) bf16x8*)(kp + koff[3] + 4096); \
        _Pragma("unroll") for (int d0 = 4; d0 < 6; ++d0) { kb_[2 * (d0 - 3)] = *(const __attribute__((address_space(3))) bf16x8*)(kr + koff[d0]); kb_[2 * (d0 - 3) + 1] = *(const __attribute__((address_space(3))) bf16x8*)(kr + koff[d0] + 2048); } \
        PN0 = __builtin_amdgcn_mfma_f32_32x32x16_bf16(ka_[0], qr[0], zero16, 0, 0, 0); PN1 = __builtin_amdgcn_mfma_f32_32x32x16_bf16(ka_[1], qr[0], zero16, 0, 0, 0); \
        _Pragma("unroll") for (int d0 = 1; d0 < 3; ++d0) { PN0 = __builtin_amdgcn_mfma_f32_32x32x16_bf16(ka_[2 * d0], qr[d0], PN0, 0, 0, 0); PN1 = __builtin_amdgcn_mfma_f32_32x32x16_bf16(ka_[2 * d0 + 1], qr[d0], PN1, 0, 0, 0); } \
        _Pragma("unroll") for (int d0 = 3; d0 < 6; ++d0) { PN0 = __builtin_amdgcn_mfma_f32_32x32x16_bf16(kb_[2 * (d0 - 3)], qr[d0], PN0, 0, 0, 0); PN1 = __builtin_amdgcn_mfma_f32_32x32x16_bf16(kb_[2 * (d0 - 3) + 1], qr[d0], PN1, 0, 0, 0); } } while (0)
#define ATTB_FMASK(PN0, PN1, tt) do { const int jb_ = (tt) - (NT - 4); \
        if (jb_ >= 0) { const int kb = 64 * jb_ + 4 * hi; \
            _Pragma("unroll") for (int r = 0; r < 16; ++r) { const int kv = kb + (r & 3) + 8 * (r >> 2); if (kv > qrel) PN0[r] = -INFINITY; if (kv + 32 > qrel) PN1[r] = -INFINITY; } } } while (0)
#define ATTB_FEXP(P0_, P1_) do { _Pragma("unroll") for (int r = 0; r < 16; ++r) { P0_[r] = __builtin_amdgcn_exp2f(P0_[r]); P1_[r] = __builtin_amdgcn_exp2f(P1_[r]); } } while (0)
#define ATTB_FSUMPACK(PC0, PC1) do { l_run += rowsum32(PC0, PC1); \
        _Pragma("unroll") for (int k = 0; k < 2; ++k) { pw[k] = (u32x4){cvtpk(PC0[8 * k], PC0[8 * k + 1]), cvtpk(PC0[8 * k + 2], PC0[8 * k + 3]), cvtpk(PC0[8 * k + 4], PC0[8 * k + 5]), cvtpk(PC0[8 * k + 6], PC0[8 * k + 7])}; \
            pw[2 + k] = (u32x4){cvtpk(PC1[8 * k], PC1[8 * k + 1]), cvtpk(PC1[8 * k + 2], PC1[8 * k + 3]), cvtpk(PC1[8 * k + 4], PC1[8 * k + 5]), cvtpk(PC1[8 * k + 6], PC1[8 * k + 7])}; } } while (0)
#define ATTB_FPV(tt) do { const lds_cptr vp = (lds_cptr)(uintptr_t)(((unsigned)(uintptr_t)(vp0 + ((tt) % 3) * VSLOT)) & 0x3ffffu);     \
        _Pragma("unroll") for (int ks = 0; ks < 4; ++ks) \
            _Pragma("unroll") for (int d0 = 0; d0 < 2; ++d0) { \
                const s16x4 lo = vtr(vp + d0 * 4096 + ks * 1024), hh = vtr(vp + d0 * 4096 + ks * 1024 + 512); \
                const bf16x8 vf = (bf16x8){lo[0], lo[1], lo[2], lo[3], hh[0], hh[1], hh[2], hh[3]}; \
                o[d0] = __builtin_amdgcn_mfma_f32_32x32x16_bf16(__builtin_bit_cast(bf16x8, pw[ks]), vf, o[d0], 0, 0, 0); } } while (0)
        f32x16 pn0, pn1, pc0, pc1; u32x4 pw[4];
        ATTB_WAIT_BAR(0);
        ATTB_FQK(pn0, pn1, 0); ATTB_FMASK(pn0, pn1, 0); ATTB_FEXP(pn0, pn1);
        int t = 0;
        for (; t + 6 <= NT; ++t) {
            if (t > 0) { if (wid < 4) ATTB_WAIT_BAR(3); else ATTB_WAIT_BAR(2); }
            ATTB_DMA_K(t + 3, (t + 3) & 3); ATTB_DMA_V(t + 2, (t + 2) % 3);
            pc0 = pn0; pc1 = pn1;
            ATTB_FQK(pn0, pn1, t + 1);
            ATTB_FSUMPACK(pc0, pc1);
            ATTB_FPV(t);
            ATTB_FEXP(pn0, pn1);
        }
        for (; t < NT; ++t) {
            if (t > 0) ATTB_WAIT_BAR(0);
            if (t + 3 < NT) ATTB_DMA_K(t + 3, (t + 3) & 3);
            if (t + 2 < NT) ATTB_DMA_V(t + 2, (t + 2) % 3);
            pc0 = pn0; pc1 = pn1;
            if (t + 1 < NT && !ATTB_SKIP(t + 1)) { ATTB_FQK(pn0, pn1, t + 1); ATTB_FMASK(pn0, pn1, t + 1); ATTB_FEXP(pn0, pn1); }
            if (!ATTB_SKIP(t)) { ATTB_FSUMPACK(pc0, pc1); ATTB_FPV(t); }
        }
#undef ATTB_FEXP
#undef ATTB_FSUMPACK
#undef ATTB_FPV
#undef ATTB_FQK
#undef ATTB_FMASK
    }
#undef ATTB_QK
#undef ATTB_SMPV
#undef ATTB_SKIP
    { auto rr = __builtin_amdgcn_permlane32_swap(__float_as_uint(l_run), __float_as_uint(l_run), false, false); l_run = __uint_as_float(rr[0]) + __uint_as_float(rr[1]); }
    if (hi == 0) wsf[32 + r32] = l_run;
    asm volatile("s_waitcnt lgkmcnt(0)" ::: "memory");
    float rli[16];
#pragma unroll
    for (int r = 0; r < 16; ++r) rli[r] = 1.0f / wsf[32 + crow(r, hi)];
    bf16* Ow = O + (rowbase + q0 + wid * 32) * 1024 + 512 + 64 * h;
    { __attribute__((address_space(3))) bf16* stg = (__attribute__((address_space(3))) bf16*)(shm + L_OST) + wid * 2048;
#pragma unroll
      for (int r = 0; r < 16; ++r) { const int orow = crow(r, hi);
#pragma unroll
          for (int d0 = 0; d0 < 2; ++d0) stg[orow * 64 + d0 * 32 + r32] = (bf16)f2bf(o[d0][r] * rli[r]); }
      asm volatile("s_waitcnt lgkmcnt(0)" ::: "memory");
#pragma unroll
      for (int i = 0; i < 4; ++i) { const int row = i * 8 + (lane >> 3), ch = lane & 7; const u32x4 v = *(const __attribute__((address_space(3))) u32x4*)(stg + row * 64 + ch * 8); *(u32x4*)(Ow + (long)row * 1024 + ch * 8) = v; } }
    { constexpr size_t PO_STRIDE = (size_t)M * 512;
      float2 mla[4][3]; u32x4 xs[4][3];
#pragma unroll
      for (int i = 0; i < 4; ++i) { const int row = i * 8 + (lane >> 3), ch = lane & 7; const size_t m = (size_t)(rowbase + q0 + wid * 32 + row);
#pragma unroll
          for (int br = 0; br < 3; ++br) { mla[i][br] = ML[((size_t)br * M + m) * 8 + h]; xs[i][br] = *(const u32x4*)(PO + br * PO_STRIDE + m * 512 + 64 * h + ch * 8); } }
      asm volatile("" ::: "memory");
#pragma unroll
      for (int i = 0; i < 4; ++i) { const int row = i * 8 + (lane >> 3), ch = lane & 7; const size_t m = (size_t)(rowbase + q0 + wid * 32 + row);
          const float2 a = mla[i][0], bq = mla[i][1], cq = mla[i][2];
          const float mx = fmaxf(fmaxf(a.x, bq.x), cq.x);
          float w0 = a.y * __builtin_amdgcn_exp2f(a.x - mx), w1 = bq.y * __builtin_amdgcn_exp2f(bq.x - mx), w2 = cq.y * __builtin_amdgcn_exp2f(cq.x - mx);
          const float inv = 1.0f / (w0 + w1 + w2); w0 *= inv; w1 *= inv; w2 *= inv;
          const u32x4 x0 = xs[i][0], x1 = xs[i][1], x2 = xs[i][2];
          u32x4 ov;
          ov.x = cvtpk(w0 * bflo(x0.x) + w1 * bflo(x1.x) + w2 * bflo(x2.x), w0 * bfhi(x0.x) + w1 * bfhi(x1.x) + w2 * bfhi(x2.x));
          ov.y = cvtpk(w0 * bflo(x0.y) + w1 * bflo(x1.y) + w2 * bflo(x2.y), w0 * bfhi(x0.y) + w1 * bfhi(x1.y) + w2 * bfhi(x2.y));
          ov.z = cvtpk(w0 * bflo(x0.z) + w1 * bflo(x1.z) + w2 * bflo(x2.z), w0 * bfhi(x0.z) + w1 * bfhi(x1.z) + w2 * bfhi(x2.z));
          ov.w = cvtpk(w0 * bflo(x0.w) + w1 * bflo(x1.w) + w2 * bflo(x2.w), w0 * bfhi(x0.w) + w1 * bfhi(x1.w) + w2 * bfhi(x2.w));
          *(u32x4*)(O + m * 1024 + 64 * h + ch * 8) = ov; } }
    asm volatile("s_waitcnt vmcnt(0) lgkmcnt(0)\n\ts_barrier" ::: "memory");
#undef ATTB_DMA
#undef ATTB_DMA_K
#undef ATTB_DMA_V
}
__device__ __forceinline__ bool score_bound_ok(const float* g_qb, const float* g_kb) {
    int l_ = threadIdx.x; asm volatile("" : "+v"(l_)); const int l = l_ & 63;
    float gq = fmaxf(fabsf(g_qb[l]), fabsf(g_qb[32 + (l & 31)])); gq = fmaxf(gq, fabsf(g_qb[64 + (l & 31)])); float gk = fmaxf(fabsf(g_kb[l]), fabsf(g_kb[64 + (l & 31)]));
#pragma unroll
    for (int o_ = 1; o_ < 64; o_ <<= 1) { gq = fmaxf(gq, __shfl_xor(gq, o_)); gk = fmaxf(gk, __shfl_xor(gk, o_)); }
    return __builtin_amdgcn_readfirstlane((int)(96.0f * QSCALE_B * gq * gk < 60.0f)) != 0; }
template <int VAR> __device__ __forceinline__ void phase(unsigned char* lds, int vcu, int G, const bf16* Q, const bf16* KN, const bf16* KR, const bf16* V, bf16* O, const float* g_qb, const float2* CS, const bf16* PO, const float2* ML, const bool fast) {
    for (int v = vcu; v < BATCH * HB * 8; v += G) {
        const int bh = v >> 3, s = v & 7;
        unit<VAR>(bh / HB, bh % HB, 15 - s, Q, KN, KR, V, O, (lds_ptr)lds, g_qb, CS, PO, ML, fast);
        unit<VAR>(bh / HB, bh % HB, s, Q, KN, KR, V, O, (lds_ptr)lds, g_qb, CS, PO, ML, fast);
    }
}
#undef ATTB_WAIT_BAR
}
namespace atta {
using namespace attb;
constexpr int BCOPY = 272;
constexpr int L_K = 0, L_V = 6 * 8192, L_BIAS = 12 * 8192, L_ID = L_BIAS + 4 * BCOPY * 4, L_WS = L_ID + 256, L_OST = L_WS + NWAVES * 256, L_BYTES = L_OST + NWAVES * 4096;
constexpr size_t PO_STRIDE = (size_t)M * 512;
constexpr float THR_A = 20.0f;
struct UnitA { int b, h, br, rho, c, dil; long tok0; };
__device__ __forceinline__ UnitA decode(int id) { UnitA u; const int bh = id / 48, r = id % 48, k = r & 15; u.br = r >> 4; u.b = bh >> 3; u.h = bh & 7;
    u.rho = u.br == 0 ? 0 : (u.br == 1 ? (k >> 2) : k); u.c = u.br == 0 ? k : (u.br == 1 ? (k & 3) : 0); u.dil = u.br == 0 ? 1 : (u.br == 1 ? 4 : 16); u.tok0 = (long)u.b * SEQ + u.rho; return u; }
constexpr int NUNITS = 32 * 48;
__device__ __forceinline__ bool score_bound_ok(const float* g_qa, const float* g_ka, const float* RB) {
    int l_ = threadIdx.x; asm volatile("" : "+v"(l_)); const int lane = l_ & 63;
    float gq = fabsf(g_qa[lane]), gk = fabsf(g_ka[lane]), bm = 0.f;
    for (int i = lane; i < 32 * 8; i += 64) bm = fmaxf(bm, fabsf(RB[i]) * LOG2E);
#pragma unroll
    for (int o_ = 1; o_ < 64; o_ <<= 1) { gq = fmaxf(gq, __shfl_xor(gq, o_)); gk = fmaxf(gk, __shfl_xor(gk, o_)); bm = fmaxf(bm, __shfl_xor(bm, o_)); }
    return __builtin_amdgcn_readfirstlane((int)(64.0f * QSCALE_A * gq * gk + bm < 60.0f)) != 0; }
template <int VAR> __device__ __forceinline__ void phase(unsigned char* lds, unsigned* counter, const bf16* Q, const bf16* K, const bf16* V, const float* BT, bf16* PO, float2* ML, const bool fast) {
    lds_ptr shm = (lds_ptr)lds;
    int tid_ = threadIdx.x; asm volatile("" : "+v"(tid_));
    const int tid = tid_, lane = tid & 63, r32 = lane & 31, hi = lane >> 5; const int wid = __builtin_amdgcn_readfirstlane(tid >> 6);
    const unsigned lds0 = (unsigned)(uintptr_t)shm;
    __attribute__((address_space(3))) float* wsf = (__attribute__((address_space(3))) float*)(shm + L_WS) + wid * 64;
    __attribute__((address_space(3))) float* bias = (__attribute__((address_space(3))) float*)(shm + L_BIAS);
    volatile __attribute__((address_space(3))) int* idw = (volatile __attribute__((address_space(3))) int*)(shm + L_ID);
    const lds_cptr kp0 = (lds_cptr)shm + L_K + r32 * 128;
    int koff[4];
#pragma unroll
    for (int d0 = 0; d0 < 4; ++d0) koff[d0] = ((2 * d0 + hi) ^ ((r32 >> 1) & 7)) * 16;
    const lds_cptr vp0 = (lds_cptr)shm + L_V + ((lane >> 4) & 1) * 32 + (lane & 3) * 8 + (4 * hi + ((lane & 15) >> 2)) * 64;
    bf16x8 qr[4];
    bf16x8 qn[4]; float bn[2];
#define ATTA_LOADS(u) do { \
        _Pragma("unroll") for (int e_ = 0; e_ < 2; ++e_) { const int ent_ = tid + 512 * e_, y_ = 255 - ((ent_ & 255) + (ent_ >> 8)) - 64; bn[e_] = (y_ >= 0 && y_ <= 128) ? BT[((u).br * 8 + (u).h) * 132 + y_] : -INFINITY; } \
        { const long qt_ = (u).tok0 + (long)(u).dil * (256 * (u).c + wid * 32 + r32); \
          _Pragma("unroll") for (int d0 = 0; d0 < 4; ++d0) qn[d0] = *reinterpret_cast<const bf16x8*>(Q + qt_ * 512 + 64 * (u).h + d0 * 16 + hi * 8); } } while (0)
#define ATTA_ISSUE(u) do { asm volatile("" : "+v"(qn[0]), "+v"(qn[1]), "+v"(qn[2]), "+v"(qn[3]), "+v"(bn[0]), "+v"(bn[1]));     \
        bias[(tid >> 8) * BCOPY + (tid & 255)] = bn[0]; bias[((tid >> 8) + 2) * BCOPY + (tid & 255)] = bn[1]; \
        _Pragma("unroll") for (int d0 = 0; d0 < 4; ++d0) qr[d0] = qn[d0]; \
        asm volatile("" ::: "memory"); \
        const int tmin_ = ((u).c == 0) ? 2 : 0; const int u0_ = 256 * (u).c - 128; \
        for (int tau = tmin_; tau < 6; ++tau) { const int uk = u0_ + 64 * tau; \
            glds16(K + ((u).tok0 + (long)(u).dil * (uk + wid * 8 + (lane >> 3))) * 512 + 64 * (u).h + (((lane & 7) ^ (((wid * 8 + (lane >> 3)) >> 1) & 7)) * 8), (unsigned)__builtin_amdgcn_readfirstlane(lds0 + L_K + tau * 8192 + wid * 1024)); \
            glds16(V + ((u).tok0 + (long)(u).dil * (uk + 16 * (wid & 3) + (lane >> 2))) * 512 + 64 * (u).h + (wid >> 2) * 32 + (lane & 3) * 8, (unsigned)__builtin_amdgcn_readfirstlane(lds0 + L_V + tau * 8192 + wid * 1024)); } } while (0)
    if (tid == 0) idw[0] = (int)__hip_atomic_fetch_add(counter, 1u, __ATOMIC_RELAXED, __HIP_MEMORY_SCOPE_AGENT);
    asm volatile("s_waitcnt vmcnt(0) lgkmcnt(0)\n\ts_barrier" ::: "memory");
    int id = __builtin_amdgcn_readfirstlane(idw[0]), par = 0;
    if (id >= NUNITS) return;
    UnitA u = decode(id);
    ATTA_LOADS(u); ATTA_ISSUE(u);
    for (;;) {
        if (tid == 0) idw[par ^ 1] = (int)__hip_atomic_fetch_add(counter, 1u, __ATOMIC_RELAXED, __HIP_MEMORY_SCOPE_AGENT);
        float mhat = 0.f, l_run = 0.f; f32x16 o[2]; o[0] = f32x16{}; o[1] = f32x16{}; f32x16 negm = f32x16{}; asm volatile("" : "+v"(negm));
        const int tau_min = (u.c == 0) ? 2 : 0;
        asm volatile("s_waitcnt vmcnt(0) lgkmcnt(0)\n\ts_barrier" ::: "memory");
        const int nid = __builtin_amdgcn_readfirstlane(idw[par ^ 1]); par ^= 1;
        const bool more = nid < NUNITS;
        UnitA nu = u; if (more) { nu = decode(nid); ATTA_LOADS(nu); }
        const __attribute__((address_space(3))) f32x4* biasv;
        { const int A0 = 63 - 32 * (wid & 1) - r32 + 4 * hi; biasv = (const __attribute__((address_space(3))) f32x4*)(bias + BCOPY * (A0 & 3) + (A0 & ~3)); }
        if (fast && (wid >> 1) >= tau_min) {
#define ATTA_FQK(PN0, PN1, ii) do { const lds_cptr kp = kp0 + ((wid >> 1) + (ii)) * 8192; \
            bf16x8 kf[8]; \
            _Pragma("unroll") for (int d0 = 0; d0 < 4; ++d0) { kf[2 * d0] = *(const __attribute__((address_space(3))) bf16x8*)(kp + koff[d0]); kf[2 * d0 + 1] = *(const __attribute__((address_space(3))) bf16x8*)(kp + koff[d0] + 4096); } \
            PN0 = __builtin_amdgcn_mfma_f32_32x32x16_bf16(kf[0], qr[0], zero16, 0, 0, 0); PN1 = __builtin_amdgcn_mfma_f32_32x32x16_bf16(kf[1], qr[0], zero16, 0, 0, 0); \
            _Pragma("unroll") for (int d0 = 1; d0 < 4; ++d0) { PN0 = __builtin_amdgcn_mfma_f32_32x32x16_bf16(kf[2 * d0], qr[d0], PN0, 0, 0, 0); PN1 = __builtin_amdgcn_mfma_f32_32x32x16_bf16(kf[2 * d0 + 1], qr[d0], PN1, 0, 0, 0); } } while (0)
#define ATTA_FBEXP(PN0, PN1, ii) do { const __attribute__((address_space(3))) f32x4* bp = biasv + 16 * (ii); \
            _Pragma("unroll") for (int g = 0; g < 4; ++g) { const f32x4 b0 = bp[2 * g], b1 = bp[2 * g + 8]; \
                _Pragma("unroll") for (int e = 0; e < 4; ++e) { PN0[4 * g + e] = __builtin_amdgcn_exp2f(PN0[4 * g + e] + b0[e]); PN1[4 * g + e] = __builtin_amdgcn_exp2f(PN1[4 * g + e] + b1[e]); } } } while (0)
#define ATTA_FSUMPACK(PC0, PC1) do { l_run += rowsum32(PC0, PC1); \
            _Pragma("unroll") for (int k = 0; k < 2; ++k) { pw[k] = (u32x4){cvtpk(PC0[8 * k], PC0[8 * k + 1]), cvtpk(PC0[8 * k + 2], PC0[8 * k + 3]), cvtpk(PC0[8 * k + 4], PC0[8 * k + 5]), cvtpk(PC0[8 * k + 6], PC0[8 * k + 7])}; \
                pw[2 + k] = (u32x4){cvtpk(PC1[8 * k], PC1[8 * k + 1]), cvtpk(PC1[8 * k + 2], PC1[8 * k + 3]), cvtpk(PC1[8 * k + 4], PC1[8 * k + 5]), cvtpk(PC1[8 * k + 6], PC1[8 * k + 7])}; } } while (0)
#define ATTA_FPV(ii) do { const lds_cptr vp = (lds_cptr)(uintptr_t)(((unsigned)(uintptr_t)(vp0 + ((wid >> 1) + (ii)) * 8192)) & 0x3ffffu); \
            _Pragma("unroll") for (int ks = 0; ks < 4; ++ks) \
                _Pragma("unroll") for (int d0 = 0; d0 < 2; ++d0) { \
                    const s16x4 lo = vtr(vp + d0 * 4096 + ks * 1024), hh = vtr(vp + d0 * 4096 + ks * 1024 + 512); \
                    const bf16x8 vf = (bf16x8){lo[0], lo[1], lo[2], lo[3], hh[0], hh[1], hh[2], hh[3]}; \
                    o[d0] = __builtin_amdgcn_mfma_f32_32x32x16_bf16(__builtin_bit_cast(bf16x8, pw[ks]), vf, o[d0], 0, 0, 0); } } while (0)
            const f32x16 zero16 = f32x16{}; f32x16 pa0, pa1, pb0, pb1; u32x4 pw[4];
            ATTA_FQK(pa0, pa1, 0); ATTA_FBEXP(pa0, pa1, 0);
            ATTA_FQK(pb0, pb1, 1); ATTA_FSUMPACK(pa0, pa1); ATTA_FPV(0); ATTA_FBEXP(pb0, pb1, 1);
            ATTA_FQK(pa0, pa1, 2); ATTA_FSUMPACK(pb0, pb1); ATTA_FPV(1); ATTA_FBEXP(pa0, pa1, 2);
            ATTA_FSUMPACK(pa0, pa1); ATTA_FPV(2);
#undef ATTA_FQK
#undef ATTA_FBEXP
#undef ATTA_FSUMPACK
#undef ATTA_FPV
        } else
        for (int i = 0; i < 3; ++i) {
            const int tau = (wid >> 1) + i;
            if (tau < tau_min) continue;
            const lds_cptr kp = kp0 + tau * 8192; const lds_cptr vp = vp0 + tau * 8192;
            f32x16 p0, p1;
            { bf16x8 kf[8];
#pragma unroll
              for (int d0 = 0; d0 < 4; ++d0) { kf[2 * d0] = *(const __attribute__((address_space(3))) bf16x8*)(kp + koff[d0]); kf[2 * d0 + 1] = *(const __attribute__((address_space(3))) bf16x8*)(kp + koff[d0] + 4096); }
              __builtin_amdgcn_sched_barrier(0);
              p0 = __builtin_amdgcn_mfma_f32_32x32x16_bf16(kf[0], qr[0], negm, 0, 0, 0); p1 = __builtin_amdgcn_mfma_f32_32x32x16_bf16(kf[1], qr[0], negm, 0, 0, 0);
#pragma unroll
              for (int d0 = 1; d0 < 4; ++d0) { p0 = __builtin_amdgcn_mfma_f32_32x32x16_bf16(kf[2 * d0], qr[d0], p0, 0, 0, 0); p1 = __builtin_amdgcn_mfma_f32_32x32x16_bf16(kf[2 * d0 + 1], qr[d0], p1, 0, 0, 0); }
              __builtin_amdgcn_sched_barrier(0); }
            { const __attribute__((address_space(3))) f32x4* bp = biasv + 16 * i;
#pragma unroll
              for (int g = 0; g < 4; ++g) { const f32x4 b0 = bp[2 * g], b1 = bp[2 * g + 8];
#pragma unroll
                  for (int e = 0; e < 4; ++e) { p0[4 * g + e] += b0[e]; p1[4 * g + e] += b1[e]; } } }
            const float rm = rowmax32(p0, p1);
            if (__any(rm > THR_A)) {
                const float dl = fmaxf(rm, 0.f), f = __builtin_amdgcn_exp2f(-dl);
                mhat += dl; l_run *= f;
#pragma unroll
                for (int r = 0; r < 16; ++r) { p0[r] -= dl; p1[r] -= dl; negm[r] = -mhat; }
                asm volatile("" : "+v"(negm));
                if (hi == 0) wsf[r32] = f;
                asm volatile("s_waitcnt lgkmcnt(0)" ::: "memory");
#pragma unroll
                for (int r = 0; r < 16; ++r) { const float fr = wsf[crow(r, hi)]; o[0][r] *= fr; o[1][r] *= fr; }
            }
#pragma unroll
            for (int r = 0; r < 16; ++r) { p0[r] = __builtin_amdgcn_exp2f(p0[r]); p1[r] = __builtin_amdgcn_exp2f(p1[r]); }
            l_run += rowsum32(p0, p1);
            u32x4 pw[4];
#pragma unroll
            for (int k = 0; k < 2; ++k) { pw[k] = (u32x4){cvtpk(p0[8 * k], p0[8 * k + 1]), cvtpk(p0[8 * k + 2], p0[8 * k + 3]), cvtpk(p0[8 * k + 4], p0[8 * k + 5]), cvtpk(p0[8 * k + 6], p0[8 * k + 7])};
                pw[2 + k] = (u32x4){cvtpk(p1[8 * k], p1[8 * k + 1]), cvtpk(p1[8 * k + 2], p1[8 * k + 3]), cvtpk(p1[8 * k + 4], p1[8 * k + 5]), cvtpk(p1[8 * k + 6], p1[8 * k + 7])}; }
            { s16x4 vl[8], vh[8];
#pragma unroll
              for (int i2 = 0; i2 < 8; ++i2) { vl[i2] = vtr(vp + (i2 >> 2) * 4096 + (i2 & 3) * 1024); vh[i2] = vtr(vp + (i2 >> 2) * 4096 + (i2 & 3) * 1024 + 512); }
              __builtin_amdgcn_sched_barrier(0);
#pragma unroll
              for (int ks = 0; ks < 4; ++ks)
#pragma unroll
                  for (int d0 = 0; d0 < 2; ++d0) { const int i2 = 4 * d0 + ks;
                      const bf16x8 vf = (bf16x8){vl[i2][0], vl[i2][1], vl[i2][2], vl[i2][3], vh[i2][0], vh[i2][1], vh[i2][2], vh[i2][3]};
                      o[d0] = __builtin_amdgcn_mfma_f32_32x32x16_bf16(__builtin_bit_cast(bf16x8, pw[ks]), vf, o[d0], 0, 0, 0); }
              __builtin_amdgcn_sched_barrier(0); }
        }
        asm volatile("s_waitcnt vmcnt(0) lgkmcnt(0)\n\ts_barrier" ::: "memory");
        const UnitA cu = u;
        if (more) { u = nu; ATTA_ISSUE(u); }
        const long qtok = cu.tok0 + (long)cu.dil * (256 * cu.c + wid * 32 + r32);
        { auto rr = __builtin_amdgcn_permlane32_swap(__float_as_uint(l_run), __float_as_uint(l_run), false, false); l_run = __uint_as_float(rr[0]) + __uint_as_float(rr[1]); }
        if (hi == 0) { wsf[32 + r32] = l_run; ML[((size_t)cu.br * M + qtok) * 8 + cu.h] = make_float2(mhat, l_run); }
        asm volatile("s_waitcnt lgkmcnt(0)" ::: "memory");
        float rli[16];
#pragma unroll
        for (int r = 0; r < 16; ++r) rli[r] = 1.0f / wsf[32 + crow(r, hi)];
        { __attribute__((address_space(3))) bf16* stg = (__attribute__((address_space(3))) bf16*)(shm + L_OST) + wid * 2048;
#pragma unroll
          for (int r = 0; r < 16; ++r) { const int orow = crow(r, hi);
#pragma unroll
              for (int d0 = 0; d0 < 2; ++d0) stg[orow * 64 + d0 * 32 + r32] = (bf16)f2bf(o[d0][r] * rli[r]); }
          asm volatile("s_waitcnt lgkmcnt(0)" ::: "memory");
          bf16* Pb = PO + (size_t)cu.br * PO_STRIDE + 64 * cu.h;
#pragma unroll
          for (int i = 0; i < 4; ++i) { const int row = i * 8 + (lane >> 3), ch = lane & 7; const u32x4 v = *(const __attribute__((address_space(3))) u32x4*)(stg + row * 64 + ch * 8);
              *(u32x4*)(Pb + (cu.tok0 + (long)cu.dil * (256 * cu.c + wid * 32 + row)) * 512 + ch * 8) = v; } }
        if (!more) break;
    }
    asm volatile("s_waitcnt vmcnt(0) lgkmcnt(0)\n\ts_barrier" ::: "memory");
#undef ATTA_LOADS
#undef ATTA_ISSUE
}
}
__device__ __forceinline__ bool gains_invertible(const float* g) {
    const int lane = (int)__builtin_amdgcn_mbcnt_hi(~0u, __builtin_amdgcn_mbcnt_lo(~0u, 0u));
    float mn = 3.0e38f;
#pragma unroll
    for (int j = 0; j < 4; ++j) { const f32x4 v = *((const f32x4*)g + lane + 64 * j); mn = fminf(mn, fminf(fminf(fabsf(v.x), fabsf(v.y)), fminf(fabsf(v.z), fabsf(v.w)))); }
#pragma unroll
    for (int o_ = 1; o_ < 64; o_ <<= 1) mn = fminf(mn, __shfl_xor(mn, o_));
    return __builtin_amdgcn_readfirstlane((int)(mn > 1.0e-3f && mn == mn)) != 0; }
constexpr int PER_PHASE = 8;
constexpr int N_LAUNCHES = MK_N_LAUNCHES;
struct Args { const void* in[17]; float* out; unsigned char* ws; int ph_lo, ph_hi, li, pad; };
__global__ void __launch_bounds__(NWAVES * 64, 2) fwd_kernel(Args args) {
    extern __shared__ __attribute__((aligned(16))) unsigned char lds[];
    Frame F;
    F.lds = (LAS unsigned char*)lds;
    F.MISC = (volatile LAS unsigned*)(F.lds + MISC_OFF);
    F.tid = threadIdx.x; F.lane = F.tid & 63; F.wave = __builtin_amdgcn_readfirstlane(F.tid >> 6);
    F.G = gridDim.x; { const int bx = blockIdx.x; F.vcu = (F.G % 8 == 0) ? (bx % 8) * (F.G / 8) + bx / 8 : bx; }
    unsigned char* ws = args.ws;
    F.ctl = (gu32*)(ws + WS_CTL);
    In I; I.x = (const float*)args.in[0]; I.pos = (const int*)args.in[1]; I.g_mix = (const float*)args.in[2]; I.w_in = (const float*)args.in[3]; I.g_qa = (const float*)args.in[4]; I.g_ka = (const float*)args.in[5];
    I.rel_bias = (const float*)args.in[6]; I.g_cq = (const float*)args.in[7]; I.g_ckv = (const float*)args.in[8]; I.w_uq = (const float*)args.in[9]; I.w_ukv = (const float*)args.in[10]; I.g_qb = (const float*)args.in[11];
    I.g_kb = (const float*)args.in[12]; I.w_o = (const float*)args.in[13]; I.g_ffn = (const float*)args.in[14]; I.w1 = (const float*)args.in[15]; I.w2 = (const float*)args.in[16];
    for (int u = F.tid; u < (LDS_BYTES - LDSCTL_OFF) / 4; u += NWAVES * 64) ((LAS unsigned*)(F.lds + LDSCTL_OFF))[u] = 0u;
    __syncthreads();
    XcdBarrier bar; bar.bar = (unsigned*)(F.ctl + CW_BAR); bar.x = 0; bar.st = nullptr;
    if (N_LAUNCHES != PER_PHASE) bar = xcd_barrier_post((unsigned*)(F.ctl + CW_BAR), F.MISC + 8);
#define GRID_BAR() do { if (N_LAUNCHES != PER_PHASE) xcd_barrier(bar); } while (0)
    const int lo = args.ph_lo, hi = args.ph_hi;
#define IN(k) (lo <= (k) && (k) < hi)
#define BOTH(k) (IN(k) && IN((k) + 1))
    bf16* XN = (bf16*)(ws + WS_XN);
    int sbA = -1, sbB = -1, gxn = -1;
    if (IN(0)) { p0_prologue(F, I, ws); if (BOTH(0)) GRID_BAR(); }
    if (IN(1)) {
        pg8::Gemm g{XN, (const bf16*)(ws + WS_WIN), M, NIN_PAD, D}; pg8::StaticOrder S; S.init(M, NIN_PAD, F.G, (int)blockIdx.x);
        pg8::EpiInProj E{(bf16*)(ws + WS_QA), (bf16*)(ws + WS_KA), (bf16*)(ws + WS_VA), (bf16*)(ws + WS_CQ), (bf16*)(ws + WS_CKV), (float*)(ws + WS_KR), (float*)(ws + WS_SSQCQ), (float*)(ws + WS_SSQCKV), (float*)(ws + WS_SKR),
                         I.g_qa, I.g_ka, I.g_kb, (const float2*)(ws + WS_CS), QSCALE_A};
        const int nidle = F.G - (NIN_PAD / 256 * (M / 256)) % F.G, first = F.G - nidle; const bool filler = nidle < F.G && (int)blockIdx.x >= first;
        if (filler) { p0b_items(F, I, ws, ((int)blockIdx.x - first) * NWAVES + F.wave, nidle * NWAVES, 3); __syncthreads(); }
        pg8::gemm_phase<pg8::EpiInProj, pg8::StaticOrder, PG8_ALIGN, PG8_SP2>(F.lds + RING_OFF, g, S, E);
        if (filler) p0b_items(F, I, ws, ((int)blockIdx.x - first) * NWAVES + F.wave, nidle * NWAVES, 4);
        else if (nidle >= F.G) p0b_items(F, I, ws, F.vcu * NWAVES + F.wave, F.G * NWAVES, 0);
        if (BOTH(1)) { sbA = atta::score_bound_ok(I.g_qa, I.g_ka, I.rel_bias) ? 1 : 0; sbB = attb::score_bound_ok(I.g_qb, I.g_kb) ? 1 : 0; GRID_BAR(); }
    }
    if (IN(2)) {
        { pg8::Gemm g{(const bf16*)(ws + WS_CQ), (const bf16*)(ws + WS_WUQ), M, 768, QLR}; pg8::StaticOrder S; S.init(M, 768, F.G, (int)blockIdx.x);
          pg8::EpiRowScale<12, 768> E{(const float*)(ws + WS_SSQCQ), (bf16*)(ws + WS_QB), 768};
          pg8::gemm_phase<pg8::EpiRowScale<12, 768>, pg8::StaticOrder, PG8_ALIGN, PG8_SP2>(F.lds + RING_OFF, g, S, E);
        }
        { pg8::Gemm g{(const bf16*)(ws + WS_CKV), (const bf16*)(ws + WS_WUKV), M, 1024, KVLR}; pg8::StaticOrder S; S.init(M, 1024, F.G, (int)blockIdx.x);
          pg8::EpiKV E{(const float*)(ws + WS_SSQCKV), (const float*)(ws + WS_SKR), (const float*)(ws + WS_KR), I.g_kb, (bf16*)(ws + WS_KBN), (bf16*)(ws + WS_KBR), (bf16*)(ws + WS_VB)};
          pg8::gemm_phase<pg8::EpiKV, pg8::StaticOrder, PG8_ALIGN, PG8_SP2>(F.lds + RING_OFF, g, S, E);
        }
        atta::phase<0>(lds, (unsigned*)(F.ctl + CW_AQ), (const bf16*)(ws + WS_QA), (const bf16*)(ws + WS_KA), (const bf16*)(ws + WS_VA), (const float*)(ws + WS_BIAS), (bf16*)args.out, (float2*)(ws + WS_ML), (sbA < 0 ? atta::score_bound_ok(I.g_qa, I.g_ka, I.rel_bias) : sbA != 0));
        if (BOTH(2)) GRID_BAR();
    }
    if (IN(4)) {
        attb::phase<0>(lds, F.vcu, F.G, (const bf16*)(ws + WS_QB), (const bf16*)(ws + WS_KBN), (const bf16*)(ws + WS_KBR), (const bf16*)(ws + WS_VB), (bf16*)(ws + WS_MIX), I.g_qb, (const float2*)(ws + WS_CS), (const bf16*)args.out, (const float2*)(ws + WS_ML), (sbB < 0 ? attb::score_bound_ok(I.g_qb, I.g_kb) : sbB != 0));
        if (BOTH(4)) { gxn = gains_invertible(I.g_mix) ? 1 : 0; GRID_BAR(); } }
    if (IN(5)) {
        pg8::Gemm g{(const bf16*)(ws + WS_MIX), (const bf16*)(ws + WS_WO), M, D, D}; pg8::StaticOrder S; S.init(M, D, F.G, (int)blockIdx.x);
        pg8::EpiWo E{I.x, (const float*)(ws + WS_IRX), (const float*)(ws + WS_IRX + 65536), (bf16*)(ws + WS_H1B), (float*)(ws + WS_SSQH), D, (gxn < 0 ? gains_invertible(I.g_mix) : gxn != 0)};
        pg8::gemm_phase<pg8::EpiWo, pg8::StaticOrder, PG8_ALIGN, PG8_SP2>(F.lds + RING_OFF, g, S, E);
        if (BOTH(5)) GRID_BAR();
    }
    if (IN(6)) {
        if (F.vcu & 1) { p0b_items(F, I, ws, (F.vcu >> 1) * NWAVES + F.wave, (F.G >> 1) * NWAVES, 1); __syncthreads(); }
        pg8::Gemm g{(const bf16*)(ws + WS_H1B), (const bf16*)(ws + WS_W1), M, FF, D}; pg8::StaticOrder S; S.init(M, FF, F.G, (int)blockIdx.x);
        int pm0 = -1; { pg8::Unit u0; if (S.next(0, u0)) { pm0 = u0.pm; LAS float* rsl = (LAS float*)(F.lds + RING_OFF + RING_BYTES);
            const int t_ = (int)threadIdx.x; if (t_ < 256) rsl[t_] = pg8::rstd_slots<16, 1024>((const float*)(ws + WS_SSQH), pm0 * 256 + t_); } __syncthreads(); }
        pg8::EpiRelu2 E{(const float*)(ws + WS_SSQH), (bf16*)(ws + WS_HID), FF, (const LAS float*)(F.lds + RING_OFF + RING_BYTES), pm0};
        pg8::gemm_phase<pg8::EpiRelu2, pg8::StaticOrder, PG8_ALIGN, PG8_SP2>(F.lds + RING_OFF, g, S, E);
        if (BOTH(6)) GRID_BAR();
    }
    if (IN(7)) {
        pg8::Gemm g{(const bf16*)(ws + WS_HID), (const bf16*)(ws + WS_W2), M, D, FF}; pg8::StaticOrder S; S.init(M, D, F.G, (int)blockIdx.x);
        pg8::EpiF32ResB E{(const bf16*)(ws + WS_H1B), args.out, D};
        pg8::gemm_phase<pg8::EpiF32ResB, pg8::StaticOrder, PG8_ALIGN, PG8_SP2>(F.lds + RING_OFF, g, S, E);
    }
#undef IN
#undef BOTH
}

extern "C" void kernel_launch(void* const* d_in, const int* in_sizes, int n_in, void* d_out, int out_size, void* d_ws, size_t ws_size, hipStream_t stream) {
    static int grid = 0;
    if (grid == 0) {
        if (n_in != 17 || out_size != M * D || ws_size < WS_END) { fprintf(stderr, "kernel_launch: unexpected problem shape (n_in %d out %d ws %zu)\n", n_in, out_size, ws_size); grid = -1; return; }
        int dev = 0, cus = 0, per_cu = 0;
        if (hipGetDevice(&dev) != hipSuccess || hipDeviceGetAttribute(&cus, hipDeviceAttributeMultiprocessorCount, dev) != hipSuccess) { grid = -1; return; }
        if (hipFuncSetAttribute((const void*)fwd_kernel, hipFuncAttributeMaxDynamicSharedMemorySize, LDS_BYTES) != hipSuccess) { fprintf(stderr, "kernel_launch: hipFuncSetAttribute failed\n"); grid = -1; return; }
        if (hipOccupancyMaxActiveBlocksPerMultiprocessor(&per_cu, (const void*)fwd_kernel, NWAVES * 64, LDS_BYTES) != hipSuccess || per_cu < 1) { fprintf(stderr, "kernel_launch: occupancy query says %d\n", per_cu); (void)hipGetLastError(); grid = -1; return; }
        grid = cus;
    }
    if (grid < 0) return;
    (void)hipMemsetAsync((char*)d_ws + WS_CTL, 0, CTL_ZERO_BYTES, stream);
    Args a{};
    for (int i = 0; i < 17; ++i) a.in[i] = d_in[i];
    a.out = (float*)d_out; a.ws = (unsigned char*)d_ws;
    if (N_LAUNCHES == 1) { a.ph_lo = 0; a.ph_hi = PER_PHASE; a.li = 0; hipLaunchKernelGGL(fwd_kernel, dim3(grid), dim3(NWAVES * 64), LDS_BYTES, stream, a); }
    else for (int li = 0; li < PER_PHASE; ++li) { a.ph_lo = li; a.ph_hi = li + 1; a.li = li; hipLaunchKernelGGL(fwd_kernel, dim3(grid), dim3(NWAVES * 64), LDS_BYTES, stream, a); }
}
```
